# Optimizing an MI355X kernel written in HIP

```python
import jax, jax.numpy as jnp
from jax import lax
import numpy as np

D_MODEL = 1024
BATCH = 8
SEQ = 4096
DEPTH = 4

GRID_W = 64
CTX_LEN = 256
N_MIXERS = 2
N_FOURIER_LAYERS = (DEPTH + 1) // 2
N_HGRN_LAYERS = DEPTH // 2
FOURIER_GROUPS = 4
FOURIER_GROUP_DIM = D_MODEL // FOURIER_GROUPS
HGRN_HEADS = 8
HGRN_DK = D_MODEL // HGRN_HEADS
HGRN_DV = D_MODEL // HGRN_HEADS
HGRN_KD = HGRN_HEADS * HGRN_DK
HGRN_VD = HGRN_HEADS * HGRN_DV
HGRN_PROJ = 3 * HGRN_KD + 2 * HGRN_VD
HGRN_SPLITS = (HGRN_KD, HGRN_KD + HGRN_VD, 2 * HGRN_KD + HGRN_VD, 3 * HGRN_KD + HGRN_VD)
HGRN_CHUNK = 32
LB_FLOOR = 1e-30
D_FF = 2816
N_SUB = 3
N_MOD = 3 * N_SUB
HALF = 0.5
NORM_EPS = 1e-6

kernel_name = "hybrid_fourier_hgrn2_macaron_dit"


def rms_norm(x, g):
    xf = x.astype(jnp.float32)
    y = xf * lax.rsqrt(jnp.mean(xf * xf, axis=-1, keepdims=True) + NORM_EPS)
    return (y * g.astype(jnp.float32)).astype(x.dtype)


def pre_sub(s, mod, j, g):
    return rms_norm(s, g) * (1 + mod[:, :, 3 * j + 1]) + mod[:, :, 3 * j]


def post_sub(s, y, mod, j, g, w):
    return s + w * mod[:, :, 3 * j + 2] * rms_norm(y, g)


def swiglu(h, w_in, w_out):
    gate, up = jnp.split(h @ w_in, 2, axis=-1)
    return (jax.nn.silu(gate) * up) @ w_out


def fourier_grid(h, rows):
    B, L, D = h.shape
    hf = h.astype(jnp.float32).reshape(B, rows, GRID_W, FOURIER_GROUPS, FOURIER_GROUP_DIM)
    y = jnp.fft.fftn(hf, axes=(1, 2, 4), norm="ortho").real
    return y.reshape(B, L, D).astype(h.dtype)


def fourier_seq(h):
    B, L, D = h.shape
    hf = h.astype(jnp.float32).reshape(B, L, FOURIER_GROUPS, FOURIER_GROUP_DIM)
    y = jnp.fft.fftn(hf, axes=(1, 3), norm="ortho").real
    return y.reshape(B, L, D).astype(h.dtype)


def hgrn_lower_bound(lb_logits, j):
    p = jax.nn.softmax(lb_logits.astype(jnp.float32), axis=0)
    lb = jnp.cumsum(p, axis=0) - p[0]
    return lb[j]


def forget_gate(z, lb):
    lb = lb.reshape(HGRN_HEADS, 1, HGRN_DK)
    z = z.astype(jnp.float32)
    log_f = jnp.logaddexp(jnp.log(jnp.maximum(lb, LB_FLOOR)), jnp.log1p(-lb) + jax.nn.log_sigmoid(z))
    k = (1 - lb) * jax.nn.sigmoid(-z)
    return k, log_f


def hgrn2_inputs(h, w_in, lb_f, lb_b):
    B, L, _ = h.shape
    q, v, zf, zb, g = jnp.split(h @ w_in, HGRN_SPLITS, axis=-1)
    heads = lambda a: a.reshape(B, L, HGRN_HEADS, -1).transpose(0, 2, 1, 3).astype(jnp.float32)
    q = jax.nn.silu(heads(q))
    kf, lf = forget_gate(heads(zf), lb_f)
    kb, lbw = forget_gate(heads(zb), lb_b)
    return q, heads(v), kf, lf, kb, lbw, g


def gla_chunk_scan(q, k, v, log_f, s0):
    B, H, L, _ = q.shape
    n = L // HGRN_CHUNK
    to_chunks = lambda a: jnp.moveaxis(a.reshape(B, H, n, HGRN_CHUNK, a.shape[-1]), 2, 0)
    incl = jnp.tril(jnp.ones((HGRN_CHUNK, HGRN_CHUNK), bool))[:, :, None]

    def step(s, inp):
        qi, ki, vi, gi = inp
        b = jnp.cumsum(gi, axis=2)
        diff = b[:, :, :, None, :] - b[:, :, None, :, :]
        decay = jnp.where(incl, jnp.exp(jnp.where(incl, diff, 0.0)), 0.0)
        a = jnp.einsum('bhtk,bhsk,bhtsk->bhts', qi, ki, decay)
        o = (jnp.einsum('bhts,bhsv->bhtv', a, vi)
             + jnp.einsum('bhtk,bhkv->bhtv', qi * jnp.exp(b), s))
        b_last = b[:, :, -1:, :]
        s_new = (jnp.exp(b_last[:, :, 0, :])[..., None] * s
                 + jnp.einsum('bhsk,bhsv->bhkv', ki * jnp.exp(b_last - b), vi))
        return s_new, o

    s_fin, oc = lax.scan(step, s0, (to_chunks(q), to_chunks(k), to_chunks(v), to_chunks(log_f)))
    o = jnp.moveaxis(oc, 0, 2).reshape(B, H, L, -1)
    return o, s_fin


def bidir_scan(q, kf, lf, kb, lbw, v, s_f, s_b):
    flip = lambda a: jnp.flip(a, axis=2)
    o_f, s_f_out = gla_chunk_scan(q, kf, v, lf, s_f)
    o_b, s_b_out = gla_chunk_scan(flip(q), flip(kb), flip(v), flip(lbw), s_b)
    return o_f + flip(o_b), s_f_out, s_b_out


def hgrn2_readout(o, g, g_norm, w_out, dtype):
    B, H, L, _ = o.shape
    o = rms_norm(o, g_norm).transpose(0, 2, 1, 3).reshape(B, L, HGRN_VD).astype(dtype)
    return (o * jax.nn.silu(g)) @ w_out


def setup_inputs(seed: int = 0) -> dict:
    key = jax.random.key(seed)
    ks = jax.random.split(key, 16)
    d = D_MODEL
    nrm = lambda k, shape, scale: scale * jax.random.normal(k, shape, jnp.float32)
    return {
        "x": nrm(ks[0], (BATCH, SEQ, d), 1.0),
        "c": nrm(ks[1], (BATCH, d), 1.0),
        "ctx": nrm(ks[2], (BATCH, CTX_LEN, d), 1.0),
        "c_ctx": nrm(ks[3], (d,), 1.0),
        "ada_w": nrm(ks[4], (DEPTH, d, N_MOD * d), 0.5 * d ** -0.5),
        "ada_b": nrm(ks[5], (DEPTH, N_MOD * d), 0.02),
        "norm_pre": 1.0 + nrm(ks[6], (DEPTH, N_SUB, d), 0.05),
        "norm_post": 1.0 + nrm(ks[7], (DEPTH, N_SUB, d), 0.05),
        "ffn_w_in": nrm(ks[8], (DEPTH, 2, d, 2 * D_FF), d ** -0.5),
        "ffn_w_out": nrm(ks[9], (DEPTH, 2, D_FF, d), D_FF ** -0.5),
        "fourier_w_out": nrm(ks[10], (N_FOURIER_LAYERS, d, d), d ** -0.5),
        "hgrn_w_in": nrm(ks[11], (N_HGRN_LAYERS, d, HGRN_PROJ), d ** -0.5),
        "hgrn_lb_fwd": nrm(ks[12], (N_HGRN_LAYERS, HGRN_KD), 0.5),
        "hgrn_lb_bwd": nrm(ks[13], (N_HGRN_LAYERS, HGRN_KD), 0.5),
        "hgrn_norm": 1.0 + nrm(ks[14], (N_HGRN_LAYERS, HGRN_DV), 0.05),
        "hgrn_w_out": nrm(ks[15], (N_HGRN_LAYERS, HGRN_VD, d), HGRN_VD ** -0.5),
    }


def reference(x, c, ctx, c_ctx, ada_w, ada_b, norm_pre, norm_post, ffn_w_in, ffn_w_out,
              fourier_w_out, hgrn_w_in, hgrn_lb_fwd, hgrn_lb_bwd, hgrn_norm, hgrn_w_out):
    B, L, D = x.shape
    rows = L // GRID_W
    sc, sctx = jax.nn.silu(c), jax.nn.silu(c_ctx)
    for i in range(DEPTH):
        last = i == DEPTH - 1
        is_hgrn = i % N_MIXERS == 1
        jm = i // N_MIXERS
        ctx_in = is_hgrn or not last
        mx = (sc @ ada_w[i] + ada_b[i]).reshape(B, 1, N_MOD, D)
        mc = (sctx @ ada_w[i] + ada_b[i]).reshape(1, 1, N_MOD, D)

        def ffn_sub(s, mod, j, f):
            h = pre_sub(s, mod, j, norm_pre[i, j])
            return post_sub(s, swiglu(h, ffn_w_in[i, f], ffn_w_out[i, f]), mod, j, norm_post[i, j], HALF)

        x = ffn_sub(x, mx, 0, 0)
        if ctx_in:
            ctx = ffn_sub(ctx, mc, 0, 0)

        hx = pre_sub(x, mx, 1, norm_pre[i, 1])
        if not is_hgrn:
            yx = fourier_grid(hx, rows) @ fourier_w_out[jm]
            x = post_sub(x, yx, mx, 1, norm_post[i, 1], 1)
            if not last:
                hc = pre_sub(ctx, mc, 1, norm_pre[i, 1])
                yc = fourier_seq(hc) @ fourier_w_out[jm]
                ctx = post_sub(ctx, yc, mc, 1, norm_post[i, 1], 1)
        else:
            lb_f = hgrn_lower_bound(hgrn_lb_fwd, jm)
            lb_b = hgrn_lower_bound(hgrn_lb_bwd, jm)
            hc = pre_sub(ctx, mc, 1, norm_pre[i, 1])
            qc, vc, kfc, lfc, kbc, lbc, gc = hgrn2_inputs(hc, hgrn_w_in[jm], lb_f, lb_b)
            zero = jnp.zeros((B, HGRN_HEADS, HGRN_DK, HGRN_DV), jnp.float32)
            oc, s_f, s_b = bidir_scan(qc, kfc, lfc, kbc, lbc, vc, zero, zero)
            qx, vx, kfx, lfx, kbx, lbx, gx = hgrn2_inputs(hx, hgrn_w_in[jm], lb_f, lb_b)
            ox, _, _ = bidir_scan(qx, kfx, lfx, kbx, lbx, vx, s_f, s_b)
            yx = hgrn2_readout(ox, gx, hgrn_norm[jm], hgrn_w_out[jm], x.dtype)
            x = post_sub(x, yx, mx, 1, norm_post[i, 1], 1)
            if not last:
                yc = hgrn2_readout(oc, gc, hgrn_norm[jm], hgrn_w_out[jm], ctx.dtype)
                ctx = post_sub(ctx, yc, mc, 1, norm_post[i, 1], 1)

        x = ffn_sub(x, mx, 2, 1)
        if not last:
            ctx = ffn_sub(ctx, mc, 2, 1)
    return x
```

```cpp
#include <hip/hip_runtime.h>
#include <hip/hip_cooperative_groups.h>
#include <cstdio>
#include <cstdint>
namespace cg = cooperative_groups;

#ifndef MK_MULTI
#define MK_MULTI 0
#endif

#define LAS __attribute__((address_space(3)))
typedef unsigned short bf16_t;
typedef short bf16x8 __attribute__((ext_vector_type(8)));
typedef float f32x4 __attribute__((ext_vector_type(4)));
typedef unsigned u32x4 __attribute__((ext_vector_type(4)));
typedef unsigned u32x2 __attribute__((ext_vector_type(2)));

constexpr int D = 1024, DFF = 2816, MX = 32768, MC = 2048, MT = MX + MC, NPROJ = 5120;
constexpr float EPS = 1e-6f;
constexpr int LDS_BYTES = 131072 + 16;
constexpr int NPH = 46;
constexpr size_t SZ_WIN1 = 5632ull * 1024 * 2, SZ_WOUT1 = 1024ull * 2816 * 2, SZ_SQ = 1024ull * 1024 * 2, SZ_WHIN1 = 5120ull * 1024 * 2;
constexpr size_t OFF_WIN = 0;
constexpr size_t OFF_WOUT = OFF_WIN + 8 * SZ_WIN1;
constexpr size_t OFF_WFO = OFF_WOUT + 8 * SZ_WOUT1;
constexpr size_t OFF_WHIN = OFF_WFO + 2 * SZ_SQ;
constexpr size_t OFF_WHOUT = OFF_WHIN + 2 * SZ_WHIN1;
constexpr size_t OFF_WD1 = OFF_WHOUT + 2 * SZ_SQ;
constexpr size_t OFF_W2X = OFF_WD1 + 512 * 256 * 2;
constexpr size_t OFF_W3X = OFF_W2X + 128 * 128 * 2;
constexpr size_t OFF_WC = OFF_W3X + 64 * 128 * 2;
constexpr size_t OFF_MOD = OFF_WC + 256 * 512 * 2;
constexpr size_t OFF_BAR = OFF_MOD + 4ull * 9 * 9216 * 4;
constexpr size_t OFF_CTXR = OFF_BAR + 16384;
constexpr size_t OFF_H = OFF_CTXR + (size_t)MC * D * 4;
constexpr size_t OFF_E = OFF_H + (size_t)MT * D * 2;
constexpr size_t OFF_BIG = OFF_E + (size_t)MT * D * 2;
constexpr size_t WS_END = OFF_BIG + (size_t)MT * NPROJ * 2;
constexpr size_t OFF_YP = WS_END;
constexpr size_t WS_END2 = OFF_YP + (size_t)MC * 4096 * 2;
constexpr int X24_R1 = (int)(((size_t)MT * D * 2) / 3072);
constexpr size_t OFF_X2 = WS_END2;
constexpr size_t WS_END3 = OFF_X2 + (size_t)(MT - X24_R1) * 3072;
constexpr size_t OFF_YFFN = OFF_BIG + (size_t)MT * DFF * 2;
constexpr size_t OFF_Z2 = OFF_BIG + (size_t)MT * 2048 * 2;

struct Args;
struct Args {
    const float* in[16];
    float* out;
    unsigned char* ws;
    int ph_lo, ph_hi;
};
#define AS4 __attribute__((address_space(4)))
typedef const AS4 Args* KP;

typedef __bf16 bf16x2_t __attribute__((ext_vector_type(2)));
typedef float f32x2_t __attribute__((ext_vector_type(2)));
__device__ __forceinline__ unsigned cvt_pk_bf16(float lo, float hi) { f32x2_t f = {lo, hi}; bf16x2_t v = __builtin_convertvector(f, bf16x2_t); return __builtin_bit_cast(unsigned, v); }
__device__ __forceinline__ bf16_t f2bf(float f) { return (bf16_t)(cvt_pk_bf16(f, 0.f) & 0xffffu); }
__device__ __forceinline__ float bf2f(bf16_t v) { return __uint_as_float((unsigned)v << 16); }
__device__ __forceinline__ float bflo(unsigned w) { return __uint_as_float(w << 16); }
__device__ __forceinline__ float bfhi(unsigned w) { return __uint_as_float(w & 0xffff0000u); }
__device__ __forceinline__ float wave_sum(float v) {
#pragma unroll
    for (int o = 1; o < 64; o <<= 1) v += __shfl_xor(v, o);
    return v;
}
__device__ __forceinline__ float silu_f(float g) { return g * __builtin_amdgcn_rcpf(1.f + __expf(-g)); }
__device__ __forceinline__ float clampf(float x, float lo, float hi) { return fminf(fmaxf(x, lo), hi); }
typedef unsigned u32x3 __attribute__((ext_vector_type(3)));
typedef unsigned u32x3a __attribute__((ext_vector_type(3), aligned(4)));
__device__ __forceinline__ unsigned f24(float f) { const unsigned u = __float_as_uint(f); return (u + 0x7Fu + ((u >> 8) & 1u)) >> 8; }
__device__ __forceinline__ u32x3 pack24(const f32x4 v) { const unsigned a0 = f24(v[0]), a1 = f24(v[1]), a2 = f24(v[2]), a3 = f24(v[3]);
    u32x3 d; d.x = a0 | (a1 << 24); d.y = (a1 >> 8) | (a2 << 16); d.z = (a2 >> 16) | (a3 << 8); return d; }
__device__ __forceinline__ f32x4 unpack24(const u32x3 d) { f32x4 v;
    v[0] = __uint_as_float(d.x << 8); v[1] = __uint_as_float(((d.x >> 24) | (d.y << 8)) << 8); v[2] = __uint_as_float(((d.y >> 16) | (d.z << 16)) << 8); v[3] = __uint_as_float(d.z & 0xFFFFFF00u); return v; }
__device__ __forceinline__ unsigned char* x24_row(unsigned char* ws, int row) { return row < X24_R1 ? ws + OFF_E + (size_t)row * 3072 : ws + OFF_X2 + (size_t)(row - X24_R1) * 3072; }

namespace pg8 {
constexpr int BM = 256, BK = 64, HALF = 128, HTB = HALF * BK * 2, NXCD = 8, WGM = 8;
__host__ __device__ __forceinline__ int lds_byte(int r, int c) { const int st = (r >> 4) * 2 + (c >> 5), rr = r & 15, cc = c & 31, ob = rr * 64 + cc * 2; return st * 1024 + (ob ^ (((ob >> 9) & 1) << 5)); }
__host__ __device__ __forceinline__ void stage_rc(int b, int& R, int& C) { const int st = b / 1024, sb = b % 1024, swz = sb ^ (((sb >> 9) & 1) << 5); R = (st >> 1) * 16 + swz / 64; C = (st & 1) * 32 + (swz % 64) / 2; }
__host__ __device__ __forceinline__ int perm32(int rho) { const int n = rho >> 4, i = rho & 15; return 8 * (i >> 2) + 4 * n + (i & 3); }

struct Unit { int pm, pn; };
struct Gemm { const bf16_t* A; const bf16_t* Bt; int M, N, K, lda, ldb, grpN, splitk; };
__device__ __forceinline__ int sk_off(int q) { return q < 2 ? q * 768 : 1536 + (q - 2) * 640; }
__device__ __forceinline__ int sk_len(int q) { return q < 2 ? 768 : 640; }

struct StaticOrder {
    int nM, nN, nwg, G, c;
    __device__ void init(int M, int N, int G_, int c_) { nM = M / BM; nN = N / BM; nwg = nM * nN; G = G_; c = c_; }
    __device__ bool next(int i, Unit& u) const {
        const long L = (long)i * G + c; if (L >= nwg) return false;
        int wgid = (int)L; { const int q = nwg / NXCD, r = nwg % NXCD, xcd = wgid % NXCD, off = wgid / NXCD; wgid = (xcd < r ? xcd * (q + 1) : r * (q + 1) + (xcd - r) * q) + off; }
        const int nig = WGM * nN, gid = wgid / nig, fm = gid * WGM, gsz = (nM - fm) < WGM ? (nM - fm) : WGM;
        u.pm = fm + ((wgid % nig) % gsz); u.pn = (wgid % nig) / gsz; return true;
    }
};

struct EpiF32 {
    static constexpr bool PERM = false;
    float* C; int ldc;
    __device__ __forceinline__ void operator()(const f32x4 (&acc)[2][2][4][2], const Unit& u, int wr, int wc, int fr, int fq, bool stream) const {
        const int row0 = u.pm * BM + wr * 64 + fr, col0 = u.pn * BM + wc * 32 + 4 * fq;
#pragma unroll
        for (int ai = 0; ai < 2; ++ai)
#pragma unroll
            for (int m = 0; m < 4; ++m) { float* rowp = C + (size_t)(row0 + ai * HALF + m * 16) * ldc + col0;
#pragma unroll
                for (int bj = 0; bj < 2; ++bj)
#pragma unroll
                    for (int n = 0; n < 2; ++n) *(f32x4*)(rowp + bj * HALF + n * 16) = acc[ai][bj][m][n]; }
    }
};
struct EpiBf16 {
    static constexpr bool PERM = true;
    bf16_t* O; int ldc; int act_lo_end, act_hi_start;
    __device__ __forceinline__ void operator()(const f32x4 (&acc)[2][2][4][2], const Unit& u, int wr, int wc, int fr, int fq, bool stream) const {
        const int row0 = u.pm * BM + wr * 64 + fr, col0 = u.pn * BM + wc * 32 + 8 * fq;
        const bool act = (u.pn * BM < act_lo_end) || (u.pn * BM >= act_hi_start);
#pragma unroll
        for (int ai = 0; ai < 2; ++ai)
#pragma unroll
            for (int m = 0; m < 4; ++m) { bf16_t* rowp = O + (size_t)(row0 + ai * HALF + m * 16) * ldc + col0;
#pragma unroll
                for (int bj = 0; bj < 2; ++bj) { f32x4 v0 = acc[ai][bj][m][0], v1 = acc[ai][bj][m][1];
                    if (act) {
#pragma unroll
                        for (int e = 0; e < 4; ++e) { v0[e] = silu_f(v0[e]); v1[e] = silu_f(v1[e]); } }
                    u32x4 w; w.x = cvt_pk_bf16(v0[0], v0[1]); w.y = cvt_pk_bf16(v0[2], v0[3]); w.z = cvt_pk_bf16(v1[0], v1[1]); w.w = cvt_pk_bf16(v1[2], v1[3]);
                    if (stream) __builtin_nontemporal_store(w, (u32x4*)(rowp + bj * HALF)); else *(u32x4*)(rowp + bj * HALF) = w; } }
    }
};
struct EpiSwiglu {
    static constexpr bool PERM = true;
    bf16_t* O; int ldc;
    __device__ __forceinline__ void operator()(const f32x4 (&acc)[2][2][4][2], const Unit& u, int wr, int wc, int fr, int fq, bool stream) const {
        const int row0 = u.pm * BM + wr * 64 + fr, col0 = u.pn * HALF + wc * 32 + 8 * fq;
#pragma unroll
        for (int ai = 0; ai < 2; ++ai)
#pragma unroll
            for (int m = 0; m < 4; ++m) { bf16_t* rowp = O + (size_t)(row0 + ai * HALF + m * 16) * ldc + col0;
                const f32x4 g0 = acc[ai][0][m][0], g1 = acc[ai][0][m][1], u0 = acc[ai][1][m][0], u1 = acc[ai][1][m][1];
                u32x4 w;
                w.x = cvt_pk_bf16(silu_f(g0[0]) * u0[0], silu_f(g0[1]) * u0[1]); w.y = cvt_pk_bf16(silu_f(g0[2]) * u0[2], silu_f(g0[3]) * u0[3]);
                w.z = cvt_pk_bf16(silu_f(g1[0]) * u1[0], silu_f(g1[1]) * u1[1]); w.w = cvt_pk_bf16(silu_f(g1[2]) * u1[2], silu_f(g1[3]) * u1[3]);
                if (stream) __builtin_nontemporal_store(w, (u32x4*)rowp); else *(u32x4*)rowp = w; }
    }
};

template <class Epi>
__device__ __forceinline__ void gemm_phase(LAS unsigned char* lds, const Gemm g, const StaticOrder& S, const Epi& E, const int TID) {
    const int tid = TID, wid = __builtin_amdgcn_readfirstlane(tid >> 6), lane = tid & 63, wr = wid >> 2, wc = wid & 3, fr = lane & 15, fq = lane >> 4;
    const int K = g.K, nt = K / BK;
    unsigned voffA[2], voffB[2];
#pragma unroll
    for (int i = 0; i < 2; ++i) { int R, C; stage_rc(tid * 16 + i * 8192, R, C); const int Rb = Epi::PERM ? ((R & ~31) + perm32(R & 31)) : R;
        voffA[i] = (unsigned)(R * g.lda + C) * 2u; voffB[i] = (unsigned)(Rb * g.ldb + C) * 2u; }
    const size_t kstep = (size_t)(BK * 2);
    const size_t hA = (size_t)HALF * g.lda * 2, hB = (size_t)HALF * g.ldb * 2;
    const unsigned ldsw = (unsigned)wid * 1024u;
    const int aoff = lds_byte(wr * 64 + fr, fq * 8), boff = lds_byte(wc * 32 + fr, fq * 8);
#define PG8_UA(u) ((const char*)g.A + (size_t)(u).pm * 2 * hA + (g.splitk ? (size_t)sk_off((u).pn / g.grpN) * 2 : (g.grpN ? (size_t)((u).pn / g.grpN) * K * 2 : (size_t)0)))
#define PG8_UB(u) ((const char*)g.Bt + (size_t)(g.grpN ? (u).pn % g.grpN : (u).pn) * 2 * hB + (g.splitk ? (size_t)sk_off((u).pn / g.grpN) * 2 : (size_t)0))
#define PG8_SA(b, h) (((b) * 2 + (h)) * HTB)
#define PG8_SB(b, h) ((4 + (b) * 2 + (h)) * HTB)
#define PG8_STAGE(bufoff, gbase, voff) do { _Pragma("unroll") for (int _i = 0; _i < 2; ++_i) \
        __builtin_amdgcn_global_load_lds((const unsigned*)((const char*)(gbase) + (voff)[_i]), (LAS unsigned*)(lds + (bufoff) + ldsw + _i * 8192), 16, 0, 0); } while (0)
#define PG8_LDA(dst, b, h) do { _Pragma("unroll") for (int m = 0; m < 4; ++m) _Pragma("unroll") for (int k = 0; k < 2; ++k) dst[m][k] = *(const LAS bf16x8*)(lds + PG8_SA(b, h) + aoff + m * 2048 + k * 1024); } while (0)
#define PG8_LDB(dst, b, h) do { _Pragma("unroll") for (int n = 0; n < 2; ++n) _Pragma("unroll") for (int k = 0; k < 2; ++k) dst[n][k] = *(const LAS bf16x8*)(lds + PG8_SB(b, h) + boff + n * 2048 + k * 1024); } while (0)
#define PG8_MMA(ai, bj, At, Bt) do { __builtin_amdgcn_s_setprio(1); _Pragma("unroll") for (int m = 0; m < 4; ++m) _Pragma("unroll") for (int n = 0; n < 2; ++n) _Pragma("unroll") for (int k = 0; k < 2; ++k) \
        acc[ai][bj][m][n] = __builtin_amdgcn_mfma_f32_16x16x32_bf16(Bt[n][k], At[m][k], acc[ai][bj][m][n], 0, 0, 0); __builtin_amdgcn_s_setprio(0); } while (0)
#define PG8_WAIT_V(n) asm volatile("s_waitcnt vmcnt(" #n ")" ::: "memory")
#define PG8_WAIT_L(n) asm volatile("s_waitcnt lgkmcnt(" #n ")" ::: "memory")
#define PG8_BAR __builtin_amdgcn_s_barrier()
#define PG8_SCHED __builtin_amdgcn_sched_barrier(0)
    Unit cur, nxt; int ui = 0;
    if (!S.next(0, cur)) return;
    f32x4 acc[2][2][4][2];
#pragma unroll
    for (int a = 0; a < 2; ++a)
#pragma unroll
        for (int b = 0; b < 2; ++b)
#pragma unroll
            for (int m = 0; m < 4; ++m)
#pragma unroll
                for (int n = 0; n < 2; ++n) acc[a][b][m][n] = (f32x4){0.f, 0.f, 0.f, 0.f};
    bf16x8 At[4][2], B0[2][2], B1[2][2];
    const char* cA = PG8_UA(cur); const char* cB = PG8_UB(cur);
    PG8_STAGE(PG8_SB(0, 0), cB, voffB); PG8_STAGE(PG8_SB(0, 1), cB + hB, voffB); PG8_STAGE(PG8_SA(0, 0), cA, voffA); PG8_STAGE(PG8_SA(0, 1), cA + hA, voffA);
    if (wr == 1) PG8_BAR;
    PG8_WAIT_V(2); PG8_BAR;
    PG8_STAGE(PG8_SB(1, 0), cB + kstep, voffB); PG8_STAGE(PG8_SA(1, 0), cA + kstep, voffA); PG8_STAGE(PG8_SB(1, 1), cB + hB + kstep, voffB);
    PG8_WAIT_V(6); PG8_BAR;
    for (;;) {
        const bool has_next = S.next(ui + 1, nxt);
        const char* nA = has_next ? PG8_UA(nxt) : cA; const char* nB = has_next ? PG8_UB(nxt) : cB;
        for (int t = 0; t < nt; t += 2) {
            const bool last = (t == nt - 2);
            const char* a1 = cA + (size_t)(t + 1) * kstep;
            const char* a2 = last ? nA : cA + (size_t)(t + 2) * kstep; const char* b2 = last ? nB : cB + (size_t)(t + 2) * kstep;
            const char* a3 = a2 + kstep; const char* b3 = b2 + kstep;
            PG8_LDB(B0, 0, 0); PG8_LDB(B1, 0, 1); PG8_SCHED; PG8_LDA(At, 0, 0); PG8_STAGE(PG8_SA(1, 1), a1 + hA, voffA);
            PG8_WAIT_V(8); PG8_WAIT_L(0); PG8_BAR; PG8_MMA(0, 0, At, B0); PG8_MMA(0, 1, At, B1); PG8_BAR; PG8_SCHED;
            PG8_LDA(At, 0, 1); PG8_STAGE(PG8_SB(0, 0), b2, voffB); PG8_STAGE(PG8_SB(0, 1), b2 + hB, voffB); PG8_STAGE(PG8_SA(0, 0), a2, voffA);
            PG8_WAIT_V(8); PG8_WAIT_L(0); PG8_BAR; PG8_MMA(1, 0, At, B0); PG8_MMA(1, 1, At, B1); PG8_BAR; PG8_SCHED;
            PG8_LDB(B0, 1, 0); PG8_LDB(B1, 1, 1); PG8_SCHED; PG8_LDA(At, 1, 0); PG8_STAGE(PG8_SA(0, 1), a2 + hA, voffA);
            PG8_WAIT_V(8); PG8_WAIT_L(0); PG8_BAR; PG8_MMA(0, 0, At, B0); PG8_MMA(0, 1, At, B1); PG8_BAR; PG8_SCHED;
            PG8_LDA(At, 1, 1); PG8_STAGE(PG8_SB(1, 0), b3, voffB); PG8_STAGE(PG8_SB(1, 1), b3 + hB, voffB); PG8_STAGE(PG8_SA(1, 0), a3, voffA);
            PG8_WAIT_V(8); PG8_WAIT_L(0); PG8_BAR; PG8_MMA(1, 0, At, B0); PG8_MMA(1, 1, At, B1); PG8_BAR; PG8_SCHED;
        }
        if (wr == 0) PG8_BAR;
        E(acc, cur, wr, wc, fr, fq, !has_next);
        if (!has_next) break;
#pragma unroll
        for (int a = 0; a < 2; ++a)
#pragma unroll
            for (int b = 0; b < 2; ++b)
#pragma unroll
                for (int m = 0; m < 4; ++m)
#pragma unroll
                    for (int n = 0; n < 2; ++n) acc[a][b][m][n] = (f32x4){0.f, 0.f, 0.f, 0.f};
        cur = nxt; cA = nA; cB = nB; ++ui;
        if (wr == 1) PG8_BAR;
    }
    PG8_WAIT_V(0);
    PG8_BAR;
#undef PG8_UA
#undef PG8_UB
#undef PG8_SA
#undef PG8_SB
#undef PG8_STAGE
#undef PG8_LDA
#undef PG8_LDB
#undef PG8_MMA
#undef PG8_WAIT_V
#undef PG8_WAIT_L
#undef PG8_BAR
#undef PG8_SCHED
}
}

__device__ __forceinline__ int maprow_glu(int n) { return n < DFF ? (n >> 7) * 256 + (n & 127) : ((n - DFF) >> 7) * 256 + 128 + ((n - DFF) & 127); }

struct TrItem { const float* W; bf16_t* WT; int K, N, item; bool glu; };
__device__ __forceinline__ void tr_load(const TrItem& t, float (&v)[32], int lane) {
    const int nblk = t.N / 32, kb = t.item / nblk, nb = t.item % nblk, k0 = 64 * kb, n0 = 32 * nb;
    const float* p = t.W + (size_t)(k0 + (lane >> 5)) * t.N + n0 + (lane & 31);
#pragma unroll
    for (int i = 0; i < 32; ++i) v[i] = __builtin_nontemporal_load(p + (size_t)(2 * i) * t.N);
}
__device__ __forceinline__ void tr_store(const TrItem& t, const float (&v)[32], LAS float* scr, int lane) {
    const int nblk = t.N / 32, kb = t.item / nblk, nb = t.item % nblk, k0 = 64 * kb, n0 = 32 * nb;
#pragma unroll
    for (int i = 0; i < 32; ++i) scr[(2 * i + (lane >> 5)) * 33 + (lane & 31)] = v[i];
    asm volatile("s_waitcnt lgkmcnt(0)" ::: "memory");
    const int c = lane & 7;
#pragma unroll
    for (int j = 0; j < 4; ++j) { const int n = (lane >> 3) + 8 * j; const LAS float* sp = scr + (8 * c) * 33 + n;
        u32x4 o; o.x = cvt_pk_bf16(sp[0 * 33], sp[1 * 33]); o.y = cvt_pk_bf16(sp[2 * 33], sp[3 * 33]); o.z = cvt_pk_bf16(sp[4 * 33], sp[5 * 33]); o.w = cvt_pk_bf16(sp[6 * 33], sp[7 * 33]);
        const int drow = t.glu ? maprow_glu(n0 + n) : n0 + n;
        *(u32x4*)(t.WT + (size_t)drow * t.K + k0 + 8 * c) = o; }
    asm volatile("s_waitcnt lgkmcnt(0)" ::: "memory");
}

__device__ __forceinline__ void dft_table(bf16_t* W, int NTOK, int M, float scale, int gtid, int gthreads, bool realin) {
    const int K = realin ? NTOK : 2 * NTOK;
    for (int idx = gtid; idx < M * K; idx += gthreads) {
        const int m = idx / K, k = idx % K, po = m / NTOK, F = m % NTOK, pi = k / NTOK, t = k % NTOK;
        const int ii = (F * t) % NTOK; const float x = 2.0f * (float)ii / (float)NTOK;
        const float cs = cospif(x), sn = sinpif(x);
        const float v = po == 0 ? (pi == 0 ? cs : -sn) : (pi == 0 ? sn : cs);
        W[idx] = f2bf(v * scale);
    }
}

__device__ __forceinline__ void phase_prologue(KP a, LAS unsigned char* lds, const int TID, const int BID, const int NBLK, int parts) {
    const int tid = TID, wid = tid >> 6, lane = tid & 63;
    if (parts & 1)
    {
        LAS float* sS = (LAS float*)lds;
        LAS float* red = (LAS float*)(lds + 36864);
        for (int idx = tid; idx < 9 * 1024; idx += 512) { const int r = idx >> 10, k = idx & 1023; const float cv = r < 8 ? a->in[1][r * 1024 + k] : a->in[3][k]; sS[idx] = cv / (1.f + __expf(-cv)); }
        __syncthreads();
        float* MOD = (float*)(a->ws + OFF_MOD);
        for (int item = BID; item < 4 * 36; item += NBLK) {
            const int L = item / 36, n0 = (item % 36) * 256;
            const float* w = a->in[4] + ((size_t)L * 1024 + wid * 128) * 9216 + n0 + 4 * lane;
            f32x4 acc[9];
#pragma unroll
            for (int r = 0; r < 9; ++r) acc[r] = (f32x4){0.f, 0.f, 0.f, 0.f};
            for (int kb = 0; kb < 128; kb += 16) { f32x4 wv[16];
#pragma unroll
                for (int u = 0; u < 16; ++u) wv[u] = __builtin_nontemporal_load((const f32x4*)(w + (size_t)(kb + u) * 9216));
#pragma unroll
                for (int u = 0; u < 16; ++u)
#pragma unroll
                    for (int r = 0; r < 9; ++r) acc[r] = acc[r] + wv[u] * sS[r * 1024 + wid * 128 + kb + u]; }
            LAS f32x4* red4 = (LAS f32x4*)(lds + 36864);
#pragma unroll
            for (int r = 0; r < 9; ++r) red4[(wid * 9 + r) * 64 + lane] = acc[r];
            __syncthreads();
            for (int idx = tid; idx < 9 * 64; idx += 512) { const int r = idx >> 6, cc = idx & 63;
                f32x4 sum = *(const f32x4*)(a->in[5] + L * 9216 + n0 + 4 * cc);
#pragma unroll
                for (int q = 0; q < 8; ++q) sum = sum + red4[(q * 9 + r) * 64 + cc];
                *(f32x4*)(MOD + ((size_t)L * 9 + r) * 9216 + n0 + 4 * cc) = sum; }
            __syncthreads();
        }
    }
    if (parts & 2) {
        const int gtid = BID * 512 + tid, gth = NBLK * 512;
        dft_table((bf16_t*)(a->ws + OFF_WD1), 256, 512, 1.f / 16.f, gtid, gth, true);
        dft_table((bf16_t*)(a->ws + OFF_W2X), 64, 128, 1.f / 8.f, gtid, gth, false);
        dft_table((bf16_t*)(a->ws + OFF_W3X), 64, 64, 1.f / 8.f, gtid, gth, false);
        dft_table((bf16_t*)(a->ws + OFF_WC), 256, 256, 1.f / 16.f, gtid, gth, false);
    }
    if (parts & 4) {
        LAS float* scr = (LAS float*)(lds + wid * 8448);
        const int gw = BID * 8 + wid, NW = NBLK * 8;
        constexpr int I_IN = 16 * 176, I_OUT = 44 * 32, I_SQ = 16 * 32, I_HIN = 16 * 160;
        constexpr int T0 = 8 * I_IN, T1 = T0 + 8 * I_OUT, T2 = T1 + 2 * I_SQ, T3 = T2 + 2 * I_HIN, T4 = T3 + 2 * I_SQ;
        auto decode = [&](int it, TrItem& t) {
            if (it < T0) { const int mi = it / I_IN; t.W = a->in[8] + (size_t)mi * 1024 * 5632; t.K = 1024; t.N = 5632; t.WT = (bf16_t*)(a->ws + OFF_WIN + mi * SZ_WIN1); t.item = it % I_IN; t.glu = true; }
            else if (it < T1) { const int r = it - T0, mi = r / I_OUT; t.W = a->in[9] + (size_t)mi * 2816 * 1024; t.K = 2816; t.N = 1024; t.WT = (bf16_t*)(a->ws + OFF_WOUT + mi * SZ_WOUT1); t.item = r % I_OUT; t.glu = false; }
            else if (it < T2) { const int r = it - T1, mi = r / I_SQ; t.W = a->in[10] + (size_t)mi * 1024 * 1024; t.K = 1024; t.N = 1024; t.WT = (bf16_t*)(a->ws + OFF_WFO + mi * SZ_SQ); t.item = r % I_SQ; t.glu = false; }
            else if (it < T3) { const int r = it - T2, mi = r / I_HIN; t.W = a->in[11] + (size_t)mi * 1024 * 5120; t.K = 1024; t.N = 5120; t.WT = (bf16_t*)(a->ws + OFF_WHIN + mi * SZ_WHIN1); t.item = r % I_HIN; t.glu = false; }
            else { const int r = it - T3, mi = r / I_SQ; t.W = a->in[15] + (size_t)mi * 1024 * 1024; t.K = 1024; t.N = 1024; t.WT = (bf16_t*)(a->ws + OFF_WHOUT + mi * SZ_SQ); t.item = r % I_SQ; t.glu = false; } };
        for (int it = gw; it < T4; it += 2 * NW) {
            TrItem t0, t1; float v0[32], v1[32];
            const bool has1 = it + NW < T4;
            decode(it, t0); tr_load(t0, v0, lane);
            if (has1) { decode(it + NW, t1); tr_load(t1, v1, lane); }
            tr_store(t0, v0, scr, lane);
            if (has1) tr_store(t1, v1, scr, lane);
        }
    }
}

constexpr int EWR = 1;
__device__ __forceinline__ void phase_ew(KP a, int lpost, int jpost, float wpost, const bf16_t* Y, int lpre, int jpre, bool first, int M, const int TID, const int BID, const int NBLK, const bf16_t* YP = nullptr) {
    const int wid = TID >> 6, lane = TID & 63;
    const float* MOD = (const float*)(a->ws + OFF_MOD);
    const bool fin = lpre < 0;
    bf16_t* H = (bf16_t*)(a->ws + OFF_H);
    const int gw = BID * 8 + wid, NW = NBLK * 8, rpw = (M + NW - 1) / NW;
    const int rbeg = gw * rpw, rend = min(M, rbeg + rpw);
    int cur_mr = -1;
    f32x4 cg[4], cp[4], sh4[4];
#pragma unroll
    for (int j = 0; j < 4; ++j) { cg[j] = (f32x4){0.f, 0.f, 0.f, 0.f}; cp[j] = cg[j]; sh4[j] = cg[j]; }
    for (int rowb = rbeg; rowb < rend; rowb += EWR) {
        int rows[EWR]; bool ok[EWR];
#pragma unroll
        for (int u = 0; u < EWR; ++u) { rows[u] = rowb + u; ok[u] = rows[u] < rend; if (!ok[u]) rows[u] = rowb; }
        f32x4 xv[EWR][4]; u32x2 yr[EWR][4];
        unsigned char* xr[EWR]; int mr[EWR];
#pragma unroll
        for (int u = 0; u < EWR; ++u) { const int row = rows[u]; mr[u] = row < MX ? (row >> 12) : 8;
            xr[u] = x24_row(a->ws, row) + 12 * lane;
            if (first) { const float* xs = row < MX ? a->in[0] + (size_t)row * D : a->in[2] + (size_t)(row - MX) * D;
#pragma unroll
                for (int j = 0; j < 4; ++j) xv[u][j] = __builtin_nontemporal_load((const f32x4*)(xs + 4 * lane + 256 * j));
            } else {
#pragma unroll
                for (int j = 0; j < 4; ++j) xv[u][j] = unpack24(__builtin_nontemporal_load((const u32x3a*)(xr[u] + 768 * j))); }
            if (lpost >= 0) {
                if (YP != nullptr && row >= MX) {
#pragma unroll
                    for (int j = 0; j < 4; ++j) { float s0 = 0.f, s1 = 0.f, s2 = 0.f, s3 = 0.f;
#pragma unroll
                        for (int q = 0; q < 4; ++q) { const u32x2 w = *(const u32x2*)(YP + (size_t)(row - MX) * 4096 + q * 1024 + 4 * lane + 256 * j); s0 += bflo(w.x); s1 += bfhi(w.x); s2 += bflo(w.y); s3 += bfhi(w.y); }
                        yr[u][j].x = cvt_pk_bf16(s0, s1); yr[u][j].y = cvt_pk_bf16(s2, s3); }
                } else {
#pragma unroll
                    for (int j = 0; j < 4; ++j) yr[u][j] = __builtin_nontemporal_load((const u32x2*)(Y + (size_t)row * D + 4 * lane + 256 * j)); } } }
#pragma unroll
        for (int u = 0; u < EWR; ++u) {
            const int row = rows[u];
            if (mr[u] != cur_mr) {
                cur_mr = mr[u];
                if (lpost >= 0) { const float* gate = MOD + ((size_t)lpost * 9 + cur_mr) * 9216 + (3 * jpost + 2) * 1024; const float* gp = a->in[7] + (lpost * 3 + jpost) * 1024;
#pragma unroll
                    for (int j = 0; j < 4; ++j) cg[j] = *(const f32x4*)(gate + 4 * lane + 256 * j) * *(const f32x4*)(gp + 4 * lane + 256 * j); }
                if (lpre >= 0) { const float* sh = MOD + ((size_t)lpre * 9 + cur_mr) * 9216 + (3 * jpre) * 1024; const float* gp = a->in[6] + (lpre * 3 + jpre) * 1024;
#pragma unroll
                    for (int j = 0; j < 4; ++j) { sh4[j] = *(const f32x4*)(sh + 4 * lane + 256 * j); cp[j] = *(const f32x4*)(gp + 4 * lane + 256 * j) * (*(const f32x4*)(sh + 1024 + 4 * lane + 256 * j) + 1.f); } }
            }
            if (lpost >= 0) {
                f32x4 yv[4]; float ss = 0.f;
#pragma unroll
                for (int j = 0; j < 4; ++j) { yv[j] = (f32x4){bflo(yr[u][j].x), bfhi(yr[u][j].x), bflo(yr[u][j].y), bfhi(yr[u][j].y)}; ss += (yv[j][0] * yv[j][0] + yv[j][1] * yv[j][1]) + (yv[j][2] * yv[j][2] + yv[j][3] * yv[j][3]); }
                ss = wave_sum(ss);
                const float r = wpost * rsqrtf(ss * (1.f / D) + EPS);
#pragma unroll
                for (int j = 0; j < 4; ++j) xv[u][j] = xv[u][j] + (yv[j] * r) * cg[j];
            }
            if (ok[u]) {
                if (fin) {
#pragma unroll
                    for (int j = 0; j < 4; ++j) __builtin_nontemporal_store(xv[u][j], (f32x4*)(a->out + (size_t)row * D + 4 * lane + 256 * j));
                } else if (lpost >= 0 || first) {
#pragma unroll
                    for (int j = 0; j < 4; ++j) __builtin_nontemporal_store(pack24(xv[u][j]), (u32x3a*)(xr[u] + 768 * j));
                }
            }
            if (lpre >= 0 && ok[u]) {
                float ss = 0.f;
#pragma unroll
                for (int j = 0; j < 4; ++j) ss += (xv[u][j][0] * xv[u][j][0] + xv[u][j][1] * xv[u][j][1]) + (xv[u][j][2] * xv[u][j][2] + xv[u][j][3] * xv[u][j][3]);
                ss = wave_sum(ss);
                const float r = rsqrtf(ss * (1.f / D) + EPS);
#pragma unroll
                for (int j = 0; j < 4; ++j) { const f32x4 hv = (xv[u][j] * r) * cp[j] + sh4[j];
                    u32x2 w; w.x = cvt_pk_bf16(hv[0], hv[1]); w.y = cvt_pk_bf16(hv[2], hv[3]);
                    *(u32x2*)(H + (size_t)row * D + 4 * lane + 256 * j) = w; }
            }
        }
    }
}

template <int NTOK, int MPARTS>
__device__ __forceinline__ void token_stage(LAS unsigned char* lds, const bf16_t* Zin, bf16_t* Zout, const bf16_t* W, int nlines, int mode, const int TID, const int BID, const int NBLK) {
    constexpr int K = 2 * NTOK, M = MPARTS * NTOK, MTW = M / 32, KS = K / 32, OLD = MPARTS == 2 ? 2048 : 1024;
    LAS unsigned* T = (LAS unsigned*)lds;
    LAS bf16_t* T16 = (LAS bf16_t*)lds;
    const int tid = TID, wid = tid >> 6, lane = tid & 63, fr = lane & 15, fq = lane >> 4, nt = wid & 3, mh = wid >> 2;
    for (int item = BID; item < nlines * 16; item += NBLK) {
        const int l = item >> 4, cb = item & 15, g = cb >> 2, F0 = (cb & 3) * 64;
        int row0, rs;
        if (mode == 0) { row0 = (l >> 6) * 4096 + (l & 63) * 64; rs = 1; } else if (mode == 1) { row0 = (l >> 6) * 4096 + (l & 63); rs = 64; } else { row0 = MX + l * 256; rs = 1; }
        for (int idx = tid; idx < K * 8; idx += 512) { const int k = idx >> 3, c8 = idx & 7, part = k / NTOK, t = k % NTOK;
            const u32x4 v = *(const u32x4*)(Zin + (size_t)(row0 + t * rs) * 2048 + g * 512 + part * 256 + F0 + c8 * 8);
            LAS unsigned* d = T + k * 33 + c8 * 4; d[0] = v.x; d[1] = v.y; d[2] = v.z; d[3] = v.w; }
        __syncthreads();
        f32x4 acc[MTW];
#pragma unroll
        for (int i = 0; i < MTW; ++i) acc[i] = (f32x4){0.f, 0.f, 0.f, 0.f};
#pragma unroll 2
        for (int ks = 0; ks < KS; ++ks) {
            bf16x8 b;
#pragma unroll
            for (int j = 0; j < 8; ++j) b[j] = (short)T16[(ks * 32 + fq * 8 + j) * 66 + nt * 16 + fr];
#pragma unroll
            for (int i = 0; i < MTW; ++i) { const bf16x8 av = *(const bf16x8*)(W + (size_t)((mh * MTW + i) * 16 + fr) * K + ks * 32 + fq * 8);
                acc[i] = __builtin_amdgcn_mfma_f32_16x16x32_bf16(av, b, acc[i], 0, 0, 0); }
        }
        __syncthreads();
#pragma unroll
        for (int i = 0; i < MTW; ++i)
#pragma unroll
            for (int j = 0; j < 4; ++j) T16[((mh * MTW + i) * 16 + fq * 4 + j) * 66 + nt * 16 + fr] = f2bf(acc[i][j]);
        __syncthreads();
        for (int idx = tid; idx < M * 8; idx += 512) { const int m = idx >> 3, c8 = idx & 7, part = m / NTOK, F = m % NTOK;
            const LAS unsigned* s = T + m * 33 + c8 * 4; u32x4 v; v.x = s[0]; v.y = s[1]; v.z = s[2]; v.w = s[3];
            const int col = MPARTS == 2 ? g * 512 + part * 256 + F0 + c8 * 8 : g * 256 + F0 + c8 * 8;
            *(u32x4*)(Zout + (size_t)(row0 + F * rs) * OLD + col) = v; }
        __syncthreads();
    }
}

template <int MPARTS>
__device__ __forceinline__ void token_stage_x(LAS unsigned char* lds, const bf16_t* Zin, bf16_t* Zout, const bf16_t* W, int mode, const int TID, const int BID, const int NBLK) {
    constexpr int NTOK = 64, K = 128, M = MPARTS * NTOK, MTW = M / 32, KS = 4, OLD = MPARTS == 2 ? 2048 : 1024, TB = K * 33 * 4;
    const int tid = TID, wid = tid >> 6, lane = tid & 63, fr = lane & 15, fq = lane >> 4, nt = wid & 3, mh = wid >> 2;
    LAS unsigned* OT = (LAS unsigned*)(lds + 2 * TB);
    LAS bf16_t* OT16 = (LAS bf16_t*)(lds + 2 * TB);
    bf16x8 wf[MTW][KS];
#pragma unroll
    for (int i = 0; i < MTW; ++i)
#pragma unroll
        for (int ks = 0; ks < KS; ++ks) wf[i][ks] = *(const bf16x8*)(W + (size_t)((mh * MTW + i) * 16 + fr) * K + ks * 32 + fq * 8);
    const int nitems = 512 * 16;
    const int k0 = tid >> 3, k1 = k0 + 64, c8 = tid & 7;
    u32x4 r0v, r1v;
    auto item_rows = [&](int item, int& row0, int& rs, int& colb) { const int l = item >> 4, cb = item & 15, g = cb >> 2, F0 = (cb & 3) * 64;
        if (mode == 0) { row0 = (l >> 6) * 4096 + (l & 63) * 64; rs = 1; } else { row0 = (l >> 6) * 4096 + (l & 63); rs = 64; }
        colb = g * 512 + F0; };
    int item = BID;
    if (item < nitems) { int row0, rs, colb; item_rows(item, row0, rs, colb);
        const bf16_t* src = Zin + (size_t)(row0 + k0 * rs) * 2048 + colb + c8 * 8; r0v = __builtin_nontemporal_load((const u32x4*)src); r1v = __builtin_nontemporal_load((const u32x4*)(src + 256)); }
    int cur = 0;
    if (item < nitems) { LAS unsigned* T = (LAS unsigned*)(lds + cur * TB); LAS unsigned* d0 = T + k0 * 33 + c8 * 4; LAS unsigned* d1 = T + k1 * 33 + c8 * 4;
        d0[0] = r0v.x; d0[1] = r0v.y; d0[2] = r0v.z; d0[3] = r0v.w; d1[0] = r1v.x; d1[1] = r1v.y; d1[2] = r1v.z; d1[3] = r1v.w; }
    { const int nx = item + NBLK; if (nx < nitems) { int row0, rs, colb; item_rows(nx, row0, rs, colb);
        const bf16_t* src = Zin + (size_t)(row0 + k0 * rs) * 2048 + colb + c8 * 8; r0v = __builtin_nontemporal_load((const u32x4*)src); r1v = __builtin_nontemporal_load((const u32x4*)(src + 256)); } }
    for (; item < nitems; item += NBLK) {
        int row0, rs, colb; item_rows(item, row0, rs, colb);
        const LAS bf16_t* T16 = (const LAS bf16_t*)(lds + cur * TB);
        __syncthreads();
        f32x4 acc[MTW];
#pragma unroll
        for (int i = 0; i < MTW; ++i) acc[i] = (f32x4){0.f, 0.f, 0.f, 0.f};
#pragma unroll
        for (int ks = 0; ks < KS; ++ks) {
            bf16x8 b;
#pragma unroll
            for (int j = 0; j < 8; ++j) b[j] = (short)T16[(ks * 32 + fq * 8 + j) * 66 + nt * 16 + fr];
#pragma unroll
            for (int i = 0; i < MTW; ++i) acc[i] = __builtin_amdgcn_mfma_f32_16x16x32_bf16(wf[i][ks], b, acc[i], 0, 0, 0);
        }
#pragma unroll
        for (int i = 0; i < MTW; ++i)
#pragma unroll
            for (int j = 0; j < 4; ++j) OT16[((mh * MTW + i) * 16 + fq * 4 + j) * 66 + nt * 16 + fr] = f2bf(acc[i][j]);
        if (item + NBLK < nitems) {
            LAS unsigned* T = (LAS unsigned*)(lds + (cur ^ 1) * TB); LAS unsigned* d0 = T + k0 * 33 + c8 * 4; LAS unsigned* d1 = T + k1 * 33 + c8 * 4;
            d0[0] = r0v.x; d0[1] = r0v.y; d0[2] = r0v.z; d0[3] = r0v.w; d1[0] = r1v.x; d1[1] = r1v.y; d1[2] = r1v.z; d1[3] = r1v.w;
            const int nx = item + 2 * NBLK;
            if (nx < nitems) { int row0n, rsn, colbn; item_rows(nx, row0n, rsn, colbn);
                const bf16_t* src = Zin + (size_t)(row0n + k0 * rsn) * 2048 + colbn + c8 * 8; r0v = __builtin_nontemporal_load((const u32x4*)src); r1v = __builtin_nontemporal_load((const u32x4*)(src + 256)); }
        }
        __syncthreads();
        for (int idx = tid; idx < M * 8; idx += 512) { const int m = idx >> 3, cc = idx & 7, part = m / NTOK, F = m % NTOK;
            const LAS unsigned* sp = OT + m * 33 + cc * 4; u32x4 v; v.x = sp[0]; v.y = sp[1]; v.z = sp[2]; v.w = sp[3];
            const int col = MPARTS == 2 ? colb + part * 256 + cc * 8 : (colb >> 9) * 256 + (colb & 511) + cc * 8;
            *(u32x4*)(Zout + (size_t)(row0 + F * rs) * OLD + col) = v; }
        cur ^= 1;
    }
    __syncthreads();
}

__device__ __forceinline__ void phase_scan(KP a, LAS unsigned char* lds, int jm, const int TID, const int BID, const int NBLK) {
    const bf16_t* P = (const bf16_t*)(a->ws + OFF_BIG);
    const int tid = TID, wid = tid >> 6, lane = tid & 63, fr = lane & 15, fq = lane >> 4;
    LAS bf16_t* Qt = (LAS bf16_t*)lds;
    LAS bf16_t* Kt = (LAS bf16_t*)(lds + 17408);
    LAS bf16_t* KtT = (LAS bf16_t*)(lds + 34816);
    LAS bf16_t* VtT = (LAS bf16_t*)(lds + 53248);
    LAS bf16_t* At = (LAS bf16_t*)(lds + 62464);
    LAS bf16_t* SpT = (LAS bf16_t*)(lds + 71680);
    LAS float* em = (LAS float*)(lds + 89088);
    LAS float* el = em + 128;
    LAS float* elm = em + 256;
    LAS float* segtot = (LAS float*)(lds + 90624);
    LAS bf16_t* Ot = (LAS bf16_t*)(lds + 94720);
    for (int item = BID; item < 256; item += NBLK) {
        const int dvh = item & 1, dir = (item >> 1) & 1, h = (item >> 2) & 7, b = item >> 5;
        const int k = tid & 127, sg = __builtin_amdgcn_readfirstlane(tid >> 7);
        const float* lbl = dir ? a->in[13] : a->in[12];
        float lbv = 0.f;
        if (jm) { const float a0 = lbl[h * 128 + k], a1 = lbl[1024 + h * 128 + k]; lbv = 1.f / (1.f + __expf(a0 - a1)); }
        const float lbm = fmaxf(lbv, 1e-30f), oml = 1.f - lbv;
        f32x4 S[4];
#pragma unroll
        for (int i = 0; i < 4; ++i) S[i] = (f32x4){0.f, 0.f, 0.f, 0.f};
        const int dvl = tid & 63, ssg = __builtin_amdgcn_readfirstlane(tid >> 6);
        const unsigned cz = 2048 + dir * 1024 + h * 128 + k, cq = h * 128 + k, cv = 1024 + h * 128 + dvh * 64 + dvl;
        bf16_t* Op = (dir ? (bf16_t*)a->out : (bf16_t*)(a->ws + OFF_H)) + h * 128 + dvh * 64;
        const int mt = wid >> 1, n0 = (wid & 1) * 2;
        const int rs = dir ? -1 : 1;
        int r0_prev = 0;
        unsigned zr[16], qr[16], vr[8];
        {
            const int r0 = dir ? MX + b * 256 + 255 : MX + b * 256;
#pragma unroll
            for (int i = 0; i < 16; ++i) { const bf16_t* pr = P + (size_t)(r0 + (16 * sg + i) * rs) * NPROJ; zr[i] = pr[cz]; qr[i] = pr[cq]; }
#pragma unroll
            for (int i = 0; i < 8; ++i) vr[i] = (P + (size_t)(r0 + (8 * ssg + i) * rs) * NPROJ)[cv];
        }
        for (int c = 0; c < 68; ++c) {
            int r0;
            { int base, len, cc; if (c < 4) { base = MX + b * 256; len = 256; cc = c; } else { base = b * 4096; len = 4096; cc = c - 4; }
              r0 = dir ? base + len - 1 - cc * 64 : base + cc * 64; }
            float f[16], kr[16], qs[16];
#pragma unroll
            for (int i = 0; i < 16; ++i) { const float z = clampf(__uint_as_float(zr[i] << 16), -30.f, 30.f);
                const float e = __expf(-z), sig = __builtin_amdgcn_rcpf(1.f + e);
                f[i] = lbm + oml * sig; kr[i] = oml * e * sig; qs[i] = __uint_as_float(qr[i] << 16); }
            u32x4 vp; vp.x = vr[0] | (vr[1] << 16); vp.y = vr[2] | (vr[3] << 16); vp.z = vr[4] | (vr[5] << 16); vp.w = vr[6] | (vr[7] << 16);
            if (c + 1 < 68) {
                const int cn = c + 1; int base, len, cc; if (cn < 4) { base = MX + b * 256; len = 256; cc = cn; } else { base = b * 4096; len = 4096; cc = cn - 4; }
                const int rn = dir ? base + len - 1 - cc * 64 : base + cc * 64;
#pragma unroll
                for (int i = 0; i < 16; ++i) { const bf16_t* pr = P + (size_t)(rn + (16 * sg + i) * rs) * NPROJ; zr[i] = pr[cz]; qr[i] = pr[cq]; }
#pragma unroll
                for (int i = 0; i < 8; ++i) vr[i] = (P + (size_t)(rn + (8 * ssg + i) * rs) * NPROJ)[cv];
            }
            float g[16], T;
            if (sg < 2) { float run = 1.f;
#pragma unroll
                for (int i = 15; i >= 0; --i) { g[i] = run; run *= f[i]; }
                T = run;
            } else { float run = 1.f;
#pragma unroll
                for (int i = 0; i < 16; ++i) { run *= f[i]; g[i] = run; }
                T = run; }
            LAS float* st = segtot + (c & 1) * 512;
            st[sg * 128 + k] = T;
            __syncthreads();
            if (c > 0) { const int t = tid >> 3, pc = tid & 7;
                *(u32x4*)(Op + (size_t)(r0_prev + t * rs) * D + pc * 8) = *(const LAS u32x4*)(Ot + t * 72 + pc * 8); }
            {
                const float t0 = st[k], t1 = st[128 + k], t2 = st[256 + k], t3 = st[384 + k];
                const float mult = sg == 0 ? t1 : (sg == 3 ? t2 : 1.f);
                const bool firsthalf = sg < 2;
                unsigned kp[8];
#pragma unroll
                for (int i = 0; i < 16; i += 2) {
                    const float G0 = fmaxf(g[i] * mult, 1e-30f), G1 = fmaxf(g[i + 1] * mult, 1e-30f);
                    const float R0 = __builtin_amdgcn_rcpf(G0), R1 = __builtin_amdgcn_rcpf(G1);
                    const float q0 = qs[i] * (firsthalf ? R0 : G0), q1 = qs[i + 1] * (firsthalf ? R1 : G1);
                    const float k0 = kr[i] * (firsthalf ? G0 : R0), k1 = kr[i + 1] * (firsthalf ? G1 : R1);
                    const unsigned qw = cvt_pk_bf16(q0, q1), kw = cvt_pk_bf16(k0, k1);
                    const int tau = 16 * sg + i;
                    Qt[tau * 136 + k] = (bf16_t)(qw & 0xffffu); Qt[(tau + 1) * 136 + k] = (bf16_t)(qw >> 16);
                    Kt[tau * 136 + k] = (bf16_t)(kw & 0xffffu); Kt[(tau + 1) * 136 + k] = (bf16_t)(kw >> 16);
                    kp[i >> 1] = kw;
                }
                *(LAS u32x4*)(KtT + k * 72 + 16 * sg) = (u32x4){kp[0], kp[1], kp[2], kp[3]};
                *(LAS u32x4*)(KtT + k * 72 + 16 * sg + 8) = (u32x4){kp[4], kp[5], kp[6], kp[7]};
                if (sg == 0) { const float m_ = t0 * t1, lm_ = t2 * t3; em[k] = m_; elm[k] = lm_; el[k] = m_ * lm_; }
                *(LAS u32x4*)(VtT + dvl * 72 + 8 * ssg) = vp;
            }
            __syncthreads();
            {
                const f32x4 e4 = *(const LAS f32x4*)(em + 16 * wid + 4 * fq);
#pragma unroll
                for (int n = 0; n < 4; ++n) { const f32x4 v = S[n] * e4; u32x2 w; w.x = cvt_pk_bf16(v[0], v[1]); w.y = cvt_pk_bf16(v[2], v[3]);
                    *(LAS u32x2*)(SpT + (16 * n + fr) * 136 + 16 * wid + 4 * fq) = w; }
            }
            {
                f32x4 c0 = (f32x4){0.f, 0.f, 0.f, 0.f}, c1 = c0;
#pragma unroll
                for (int ks = 0; ks < 4; ++ks) {
                    const bf16x8 av = *(const LAS bf16x8*)(Qt + (16 * mt + fr) * 136 + 32 * ks + 8 * fq);
                    const bf16x8 b0 = *(const LAS bf16x8*)(Kt + (16 * n0 + fr) * 136 + 32 * ks + 8 * fq);
                    const bf16x8 b1 = *(const LAS bf16x8*)(Kt + (16 * (n0 + 1) + fr) * 136 + 32 * ks + 8 * fq);
                    c0 = __builtin_amdgcn_mfma_f32_16x16x32_bf16(av, b0, c0, 0, 0, 0);
                    c1 = __builtin_amdgcn_mfma_f32_16x16x32_bf16(av, b1, c1, 0, 0, 0);
                }
#pragma unroll
                for (int j = 0; j < 4; ++j) { const int t = 16 * mt + 4 * fq + j, s0 = 16 * n0 + fr, s1 = s0 + 16;
                    At[t * 72 + s0] = f2bf(s0 <= t ? c0[j] : 0.f); At[t * 72 + s1] = f2bf(s1 <= t ? c1[j] : 0.f); }
            }
            __syncthreads();
            {
                f32x4 o0 = (f32x4){0.f, 0.f, 0.f, 0.f}, o1 = o0;
#pragma unroll
                for (int ks = 0; ks < 2; ++ks) {
                    const bf16x8 av = *(const LAS bf16x8*)(At + (16 * mt + fr) * 72 + 32 * ks + 8 * fq);
                    const bf16x8 b0 = *(const LAS bf16x8*)(VtT + (16 * n0 + fr) * 72 + 32 * ks + 8 * fq);
                    const bf16x8 b1 = *(const LAS bf16x8*)(VtT + (16 * (n0 + 1) + fr) * 72 + 32 * ks + 8 * fq);
                    o0 = __builtin_amdgcn_mfma_f32_16x16x32_bf16(av, b0, o0, 0, 0, 0);
                    o1 = __builtin_amdgcn_mfma_f32_16x16x32_bf16(av, b1, o1, 0, 0, 0);
                }
#pragma unroll
                for (int ks = 0; ks < 4; ++ks) {
                    const bf16x8 av = *(const LAS bf16x8*)(Qt + (16 * mt + fr) * 136 + 32 * ks + 8 * fq);
                    const bf16x8 b0 = *(const LAS bf16x8*)(SpT + (16 * n0 + fr) * 136 + 32 * ks + 8 * fq);
                    const bf16x8 b1 = *(const LAS bf16x8*)(SpT + (16 * (n0 + 1) + fr) * 136 + 32 * ks + 8 * fq);
                    o0 = __builtin_amdgcn_mfma_f32_16x16x32_bf16(av, b0, o0, 0, 0, 0);
                    o1 = __builtin_amdgcn_mfma_f32_16x16x32_bf16(av, b1, o1, 0, 0, 0);
                }
#pragma unroll
                for (int j = 0; j < 4; ++j) { const int t = 16 * mt + 4 * fq + j;
                    Ot[t * 72 + 16 * n0 + fr] = f2bf(o0[j]); Ot[t * 72 + 16 * n0 + 16 + fr] = f2bf(o1[j]); }
                r0_prev = r0;
            }
            {
                const f32x4 l4 = *(const LAS f32x4*)(el + 16 * wid + 4 * fq), lm4 = *(const LAS f32x4*)(elm + 16 * wid + 4 * fq);
#pragma unroll
                for (int n = 0; n < 4; ++n) { f32x4 d = (f32x4){0.f, 0.f, 0.f, 0.f};
#pragma unroll
                    for (int ks = 0; ks < 2; ++ks) {
                        const bf16x8 av = *(const LAS bf16x8*)(KtT + (16 * wid + fr) * 72 + 32 * ks + 8 * fq);
                        const bf16x8 bv = *(const LAS bf16x8*)(VtT + (16 * n + fr) * 72 + 32 * ks + 8 * fq);
                        d = __builtin_amdgcn_mfma_f32_16x16x32_bf16(av, bv, d, 0, 0, 0);
                    }
                    S[n] = l4 * S[n] + lm4 * d; }
            }
        }
        __syncthreads();
        { const int t = tid >> 3, pc = tid & 7;
            *(u32x4*)(Op + (size_t)(r0_prev + t * rs) * D + pc * 8) = *(const LAS u32x4*)(Ot + t * 72 + pc * 8); }
        __syncthreads();
    }
}

__device__ __forceinline__ void phase_readout(KP a, int jm, int M, const int TID, const int BID, const int NBLK) {
    const int wid = TID >> 6, lane = TID & 63;
    bf16_t* Of = (bf16_t*)(a->ws + OFF_H);
    const bf16_t* Ob = (const bf16_t*)a->out;
    const bf16_t* P = (const bf16_t*)(a->ws + OFF_BIG);
    const float* gn = a->in[14] + jm * 128 + ((8 * lane) & 127);
    float gnv[8];
#pragma unroll
    for (int i = 0; i < 8; ++i) gnv[i] = gn[i];
    const int gw = BID * 8 + wid, NW = NBLK * 8;
    for (int row = gw; row < M; row += NW) {
        u32x4 fv[2], bv[2], gv[2];
#pragma unroll
        for (int hh = 0; hh < 2; ++hh) {
            fv[hh] = __builtin_nontemporal_load((const u32x4*)(Of + (size_t)row * D + 512 * hh + 8 * lane));
            bv[hh] = __builtin_nontemporal_load((const u32x4*)(Ob + (size_t)row * D + 512 * hh + 8 * lane));
            gv[hh] = __builtin_nontemporal_load((const u32x4*)(P + (size_t)row * NPROJ + 4096 + 512 * hh + 8 * lane)); }
#pragma unroll
        for (int hh = 0; hh < 2; ++hh) {
            const unsigned fw[4] = {fv[hh].x, fv[hh].y, fv[hh].z, fv[hh].w};
            const unsigned bw[4] = {bv[hh].x, bv[hh].y, bv[hh].z, bv[hh].w};
            const unsigned gw4[4] = {gv[hh].x, gv[hh].y, gv[hh].z, gv[hh].w};
            float o[8]; float ss = 0.f;
#pragma unroll
            for (int w = 0; w < 4; ++w) { o[2 * w] = bflo(fw[w]) + bflo(bw[w]); o[2 * w + 1] = bfhi(fw[w]) + bfhi(bw[w]); ss += o[2 * w] * o[2 * w] + o[2 * w + 1] * o[2 * w + 1]; }
            ss += __shfl_xor(ss, 1); ss += __shfl_xor(ss, 2); ss += __shfl_xor(ss, 4); ss += __shfl_xor(ss, 8);
            const float r = rsqrtf(ss * (1.f / 128.f) + EPS);
            u32x4 ov;
            ov.x = cvt_pk_bf16(o[0] * r * gnv[0] * bflo(gw4[0]), o[1] * r * gnv[1] * bfhi(gw4[0]));
            ov.y = cvt_pk_bf16(o[2] * r * gnv[2] * bflo(gw4[1]), o[3] * r * gnv[3] * bfhi(gw4[1]));
            ov.z = cvt_pk_bf16(o[4] * r * gnv[4] * bflo(gw4[2]), o[5] * r * gnv[5] * bfhi(gw4[2]));
            ov.w = cvt_pk_bf16(o[6] * r * gnv[6] * bflo(gw4[3]), o[7] * r * gnv[7] * bfhi(gw4[3]));
            *(u32x4*)(Of + (size_t)row * D + 512 * hh + 8 * lane) = ov;
        }
    }
}

template <class Epi>
__device__ __forceinline__ void run_gemm(LAS unsigned char* lds, const bf16_t* A, const bf16_t* Bt, int M, int N, int K, int lda, int ldb, int grpN, const Epi& E, const int TID, const int BID, const int NBLK, int splitk = 0) {
    pg8::Gemm g; g.A = A; g.Bt = Bt; g.M = M; g.N = N; g.K = K; g.lda = lda; g.ldb = ldb; g.grpN = grpN; g.splitk = splitk;
    pg8::StaticOrder S; S.init(M, N, NBLK, BID);
    if (splitk) { pg8::Unit u0; if (S.next(0, u0)) g.K = pg8::sk_len(u0.pn / grpN); }
    pg8::gemm_phase<Epi>(lds, g, S, E, TID);
}

__device__ __forceinline__ void run_phase(KP a, int ph, LAS unsigned char* lds, int parts = 7) {
    int TID = threadIdx.x, BID = blockIdx.x, NBLK = gridDim.x;
    asm volatile("" : "+v"(TID)); asm volatile("" : "+s"(BID)); asm volatile("" : "+s"(NBLK)); asm volatile("" : "+s"(lds));
    asm volatile("" : "+s"(a));
    unsigned char* ws = a->ws;
#ifndef SKIP_PRO
    if (ph == 0) { phase_prologue(a, lds, TID, BID, NBLK, parts); return; }
#endif
    const int q = ph - 1, L = q / 11, s = q % 11;
    const bf16_t* YF = (const bf16_t*)(ws + OFF_YFFN);
    const bf16_t* YM = (const bf16_t*)(ws + OFF_BIG);
    if (L == 4) { phase_ew(a, 3, 2, 0.5f, YF, -1, 0, false, MX, TID, BID, NBLK); return; }
    const bool last = (L == 3), hg = (L & 1);
    const int jm = L >> 1;
    const int Mmix = last ? MX : MT;
    int kind;
    if (s == 0 || s == 3 || s == 8) kind = 0;
    else if (s == 1 || s == 9) kind = 1;
    else if (s == 2 || s == 10 || s == 7) kind = 2;
    else if (s == 4) kind = 3;
    else if (s == 5) kind = hg ? 6 : 4;
    else kind = hg ? 7 : 5;
    if (kind == 0) {
#ifndef SKIP_EW
        if (s == 0) { if (L == 0) phase_ew(a, -1, 0, 0.f, YF, 0, 0, true, MT, TID, BID, NBLK); else phase_ew(a, L - 1, 2, 0.5f, YF, L, 0, false, MT, TID, BID, NBLK, (const bf16_t*)(ws + OFF_YP)); }
        else if (s == 3) phase_ew(a, L, 0, 0.5f, YF, L, 1, false, MT, TID, BID, NBLK, (const bf16_t*)(ws + OFF_YP));
        else phase_ew(a, L, 1, 1.0f, YM, L, 2, false, Mmix, TID, BID, NBLK);
#endif
    } else if (kind == 1) {
#ifndef SKIP_G1
        const int f = (s == 1) ? 0 : 1, M = (s == 1) ? MT : Mmix;
        pg8::EpiSwiglu E; E.O = (bf16_t*)(ws + OFF_BIG); E.ldc = DFF;
        run_gemm(lds, (const bf16_t*)(ws + OFF_H), (const bf16_t*)(ws + OFF_WIN + (size_t)(L * 2 + f) * SZ_WIN1), M, 2 * DFF, D, D, D, 0, E, TID, BID, NBLK);
#endif
    } else if (kind == 2) {
#ifndef SKIP_G2
        pg8::EpiBf16 E; E.act_lo_end = 0; E.act_hi_start = (1 << 30);
        const bf16_t* A2; const bf16_t* B2; int M2, K2; bf16_t* O2;
        if (s == 7) { O2 = (bf16_t*)(ws + OFF_BIG); A2 = (const bf16_t*)(ws + OFF_H); K2 = D; M2 = hg ? Mmix : MT;
            B2 = hg ? (const bf16_t*)(ws + OFF_WHOUT + (size_t)jm * SZ_SQ) : (const bf16_t*)(ws + OFF_WFO + (size_t)jm * SZ_SQ);
        } else { const int f = (s == 2) ? 0 : 1; M2 = (s == 2) ? MT : Mmix; O2 = (bf16_t*)(ws + OFF_YFFN); A2 = (const bf16_t*)(ws + OFF_BIG); K2 = DFF;
            B2 = (const bf16_t*)(ws + OFF_WOUT + (size_t)(L * 2 + f) * SZ_WOUT1); }
        const int npass = (s != 7 && M2 == MT) ? 2 : 1;
        for (int pass = 0; pass < npass; ++pass) {
            const bool sp = pass == 1;
            E.O = sp ? (bf16_t*)(ws + OFF_YP) : O2; E.ldc = sp ? 4096 : D;
            run_gemm(lds, sp ? A2 + (size_t)MX * DFF : A2, B2, sp ? MC : (npass == 2 ? MX : M2), sp ? 4096 : D, K2, K2, K2, sp ? 4 : 0, E, TID, BID, NBLK, sp ? 1 : 0);
        }
#endif
    } else if (kind == 3) {
#ifndef SKIP_G3
        pg8::EpiBf16 E; E.O = (bf16_t*)(ws + OFF_BIG); E.ldc = hg ? NPROJ : 2048; E.act_lo_end = hg ? 1024 : 0; E.act_hi_start = hg ? 4096 : (1 << 30);
        const bf16_t* B3 = hg ? (const bf16_t*)(ws + OFF_WHIN + (size_t)jm * SZ_WHIN1) : (const bf16_t*)(ws + OFF_WD1);
        run_gemm(lds, (const bf16_t*)(ws + OFF_H), B3, MT, hg ? NPROJ : 2048, hg ? D : 256, D, hg ? D : 256, hg ? 0 : 2, E, TID, BID, NBLK);
#endif
    } else if (kind == 4) {
#ifndef SKIP_T4
        token_stage_x<2>(lds, (const bf16_t*)(ws + OFF_BIG), (bf16_t*)(ws + OFF_Z2), (const bf16_t*)(ws + OFF_W2X), 0, TID, BID, NBLK);
        token_stage<256, 1>(lds, (const bf16_t*)(ws + OFF_BIG), (bf16_t*)(ws + OFF_H), (const bf16_t*)(ws + OFF_WC), 8, 2, TID, BID, NBLK);
#endif
    } else if (kind == 5) {
#ifndef SKIP_T5
        token_stage_x<1>(lds, (const bf16_t*)(ws + OFF_Z2), (bf16_t*)(ws + OFF_H), (const bf16_t*)(ws + OFF_W3X), 1, TID, BID, NBLK);
#endif
    } else if (kind == 6) {
#ifndef SKIP_SCAN
        phase_scan(a, lds, jm, TID, BID, NBLK);
#endif
    } else {
#ifndef SKIP_RO
        phase_readout(a, jm, Mmix, TID, BID, NBLK);
#endif
    }
}


#define XB_TMO      128
#define XB_XCNT(j)  (256  + 64 * (j))
#define XB_XSUB(j)  (1280 + 64 * (j))
#define XB_XGEN(j)  (2304 + 64 * (j))
#define XB_TOP      3328
#define XB_TOPGEN   3392
#define XCD_BAR_WORDS 3456
#define XB_SPIN_CAP (1u << 20)
__device__ __forceinline__ unsigned xb_ld(unsigned* p)              { return __hip_atomic_load(p, __ATOMIC_RELAXED, __HIP_MEMORY_SCOPE_AGENT); }
__device__ __forceinline__ unsigned xb_add(unsigned* p, unsigned v) { return __hip_atomic_fetch_add(p, v, __ATOMIC_RELAXED, __HIP_MEMORY_SCOPE_AGENT); }
__device__ __forceinline__ unsigned xb_xcc_id() { return (unsigned)__builtin_amdgcn_s_getreg((3 << 11) | 20) & 0xFu; }
#define XB_SPIN(cond, bar) do { unsigned _sp = 0; while (cond) { __builtin_amdgcn_s_sleep(1); \
    if ((++_sp & 255u) == 0u) { if (xb_ld(&(bar)[XB_TMO])) break; if (_sp > XB_SPIN_CAP) { atomicAdd(&(bar)[XB_TMO], 1u); break; } } } } while (0)
struct XcdBarrier { unsigned* bar; unsigned x; volatile LAS unsigned* st; };
__device__ __forceinline__ XcdBarrier xcd_barrier_post(unsigned* bar, volatile LAS unsigned* st) {
    XcdBarrier b; b.bar = bar; b.x = xb_xcc_id(); b.st = st;
    if (threadIdx.x == 0) (void)xb_add(&bar[XB_XCNT(b.x)], 1u);
    return b;
}
__device__ __forceinline__ void xcd_barrier_complete(unsigned* bar, unsigned x, unsigned& nloc, unsigned& nx) {
    const unsigned G = gridDim.x * gridDim.y * gridDim.z;
    unsigned sum, cnt, mine, sp = 0u;
    for (;;) {
        sum = 0u; cnt = 0u; mine = 0u;
#pragma unroll
        for (unsigned j = 0; j < 16; ++j) { const unsigned c = xb_ld(&bar[XB_XCNT(j)]); sum += c; cnt += (c > 0u) ? 1u : 0u; mine = (j == x) ? c : mine; }
        if (sum == G) break;
        __builtin_amdgcn_s_sleep(1);
        if ((++sp & 255u) == 0u) { if (xb_ld(&bar[XB_TMO])) break; if (sp > XB_SPIN_CAP) { atomicAdd(&bar[XB_TMO], 1u); break; } }
    }
    nloc = mine > 0u ? mine : 1u; nx = cnt > 0u ? cnt : 1u;
}
__device__ __forceinline__ void xcd_barrier(const XcdBarrier& b) {
    asm volatile("s_waitcnt vmcnt(0)" ::: "memory");
    __syncthreads();
    if (threadIdx.x == 0) {
        unsigned* bar = b.bar;
        __builtin_amdgcn_s_waitcnt(0);
        unsigned nloc = b.st[0], nx = b.st[1];
        if (nloc == 0u) { xcd_barrier_complete(bar, b.x, nloc, nx); b.st[0] = nloc; b.st[1] = nx; }
        const unsigned old = xb_add(&bar[XB_XSUB(b.x)], 1u);
        const unsigned gen = old / nloc;
        if (old + 1u == (gen + 1u) * nloc) {
            __builtin_amdgcn_fence(__ATOMIC_RELEASE, "agent");
            asm volatile("s_waitcnt vmcnt(0)" ::: "memory");
            const unsigned og = xb_add(&bar[XB_TOP], 1u);
            const unsigned tg = og / nx;
            if (og + 1u == (tg + 1u) * nx) xb_add(&bar[XB_TOPGEN], 1u);
            else XB_SPIN(xb_ld(&bar[XB_TOPGEN]) == tg, bar);
            __builtin_amdgcn_fence(__ATOMIC_ACQUIRE, "agent");
            xb_add(&bar[XB_XGEN(b.x)], 1u);
            asm volatile("s_waitcnt vmcnt(0)" ::: "memory");
        } else {
            XB_SPIN(xb_ld(&bar[XB_XGEN(b.x)]) == gen, bar);
            __builtin_amdgcn_fence(__ATOMIC_ACQUIRE, "agent");
            asm volatile("s_waitcnt vmcnt(0)" ::: "memory");
        }
    }
    __syncthreads();
}

extern "C" __global__ void __launch_bounds__(512, 2) fwd_megakernel(Args a) {
    extern __shared__ __attribute__((aligned(16))) unsigned char smem[];
    LAS unsigned char* lds = (LAS unsigned char*)smem;
    cg::grid_group grid = cg::this_grid();
    KP kp = (KP)__builtin_amdgcn_kernarg_segment_ptr();
    volatile LAS unsigned* xst = (volatile LAS unsigned*)(lds + 131072);
    if (threadIdx.x == 0) { xst[0] = 0u; xst[1] = 0u; }
    __syncthreads();
    XcdBarrier xb = xcd_barrier_post((unsigned*)(a.ws + OFF_BAR), xst);
#define GRID_SEAM(ph_) do { if ((ph_) == a.ph_lo) grid.sync(); else xcd_barrier(xb); } while (0)
    for (int ph = a.ph_lo; ph < a.ph_hi; ++ph) {
#ifdef REPEAT_MASK
        int reps = 1;
        { int q = ph - 1, L = q / 11, s = q % 11; bool hg = L & 1; int kind = -1;
          if (ph == 0) kind = 8; else if (L < 4) { if (s == 1 || s == 9) kind = 1; else if (s == 2 || s == 10 || s == 7) kind = 2; else if (s == 4) kind = 3; else if (s == 5) kind = hg ? 6 : 4; else if (s == 6) kind = hg ? 7 : 5; else kind = 0; }
          if (kind >= 0 && ((REPEAT_MASK >> kind) & 1)) reps = 2; }
        for (int r = 0; r < reps; ++r) { if (r) xcd_barrier(xb); run_phase(kp, ph, lds, (r && ph == 0) ? REPEAT_PARTS : 7); }
#else
        run_phase(kp, ph, lds);
#endif
        if (ph + 1 < a.ph_hi) GRID_SEAM(ph);
    }
}

extern "C" void kernel_launch(void* const* d_in, const int* in_sizes, int n_in, void* d_out, int out_size, void* d_ws, size_t ws_size, hipStream_t stream) {
    static int grid = 0;
    if (grid == 0) {
        if (n_in != 16 || ws_size < WS_END3) { fprintf(stderr, "kernel_launch: unexpected n_in %d / ws %zu (need %zu)\n", n_in, ws_size, (size_t)WS_END3); grid = -1; return; }
        int dev = 0, cus = 0, per_cu = 0;
        hipGetDevice(&dev);
        hipDeviceGetAttribute(&cus, hipDeviceAttributeMultiprocessorCount, dev);
        if (hipFuncSetAttribute((const void*)fwd_megakernel, hipFuncAttributeMaxDynamicSharedMemorySize, LDS_BYTES) != hipSuccess) { fprintf(stderr, "kernel_launch: hipFuncSetAttribute failed\n"); grid = -1; return; }
        hipOccupancyMaxActiveBlocksPerMultiprocessor(&per_cu, (const void*)fwd_megakernel, 512, LDS_BYTES);
        if (per_cu < 1) { fprintf(stderr, "kernel_launch: occupancy query says %d blocks per CU\n", per_cu); per_cu = 1; }
        (void)hipGetLastError();
        grid = cus * per_cu;
        if (grid > 256) grid = 256;
    }
    if (grid < 0) return;
    Args a{};
    for (int i = 0; i < 16; ++i) a.in[i] = (const float*)d_in[i];
    a.out = (float*)d_out; a.ws = (unsigned char*)d_ws;
#ifndef NPH_RUN
#define NPH_RUN NPH
#endif
#if MK_MULTI
    for (int ph = 0; ph < NPH_RUN; ++ph) { a.ph_lo = ph; a.ph_hi = ph + 1; hipLaunchKernelGGL(fwd_megakernel, dim3(grid), dim3(512), LDS_BYTES, stream, a); }
#else
    a.ph_lo = 0; a.ph_hi = NPH;
    if (hipMemsetAsync((char*)d_ws + OFF_BAR, 0, 16384, stream) != hipSuccess) { fprintf(stderr, "kernel_launch: memset of barrier words failed\n"); return; }
    void* args[] = {&a};
    hipError_t e = hipLaunchCooperativeKernel((const void*)fwd_megakernel, dim3(grid), dim3(512), args, LDS_BYTES, stream);
    if (e != hipSuccess) fprintf(stderr, "cooperative launch failed: %s (grid %d)\n", hipGetErrorString(e), grid);
#endif
}
```

```cpp
#include <hip/hip_runtime.h>
#include <hip/hip_cooperative_groups.h>
#include <cstdio>
#include <cstdint>
namespace cg = cooperative_groups;

#ifndef MK_MULTI
#define MK_MULTI 0
#endif

#define LAS __attribute__((address_space(3)))
typedef unsigned short bf16_t;
typedef short bf16x8 __attribute__((ext_vector_type(8)));
typedef float f32x4 __attribute__((ext_vector_type(4)));
typedef unsigned u32x4 __attribute__((ext_vector_type(4)));
typedef unsigned u32x2 __attribute__((ext_vector_type(2)));

constexpr int D = 1024, DFF = 2816, MX = 32768, MC = 2048, MT = MX + MC, NPROJ = 5120;
constexpr float EPS = 1e-6f;
constexpr int LDS_BYTES = 131072 + 16;
constexpr int NPH = 46;
constexpr size_t SZ_WIN1 = 5632ull * 1024 * 2, SZ_WOUT1 = 1024ull * 2816 * 2, SZ_SQ = 1024ull * 1024 * 2, SZ_WHIN1 = 5120ull * 1024 * 2;
constexpr size_t OFF_WIN = 0;
constexpr size_t OFF_WOUT = OFF_WIN + 8 * SZ_WIN1;
constexpr size_t OFF_WFO = OFF_WOUT + 8 * SZ_WOUT1;
constexpr size_t OFF_WHIN = OFF_WFO + 2 * SZ_SQ;
constexpr size_t OFF_WHOUT = OFF_WHIN + 2 * SZ_WHIN1;
constexpr size_t OFF_WD1 = OFF_WHOUT + 2 * SZ_SQ;
constexpr size_t OFF_W2X = OFF_WD1 + 512 * 256 * 2;
constexpr size_t OFF_W3X = OFF_W2X + 128 * 128 * 2;
constexpr size_t OFF_WC = OFF_W3X + 64 * 128 * 2;
constexpr size_t OFF_MOD = OFF_WC + 256 * 512 * 2;
constexpr size_t OFF_BAR = OFF_MOD + 4ull * 9 * 9216 * 4;
constexpr size_t OFF_CTXR = OFF_BAR + 16384;
constexpr size_t OFF_H = OFF_CTXR + (size_t)MC * D * 4;
constexpr size_t OFF_E = OFF_H + (size_t)MT * D * 2;
constexpr size_t OFF_BIG = OFF_E + (size_t)MT * D * 2;
constexpr size_t WS_END = OFF_BIG + (size_t)MT * NPROJ * 2;
constexpr size_t OFF_YP = WS_END;
constexpr size_t WS_END2 = OFF_YP + (size_t)MC * 4096 * 2;
constexpr int X24_R1 = (int)(((size_t)MT * D * 2) / 3072);
constexpr size_t OFF_X2 = WS_END2;
constexpr size_t WS_END3 = OFF_X2 + (size_t)(MT - X24_R1) * 3072;
constexpr size_t OFF_YFFN = OFF_BIG + (size_t)MT * DFF * 2;
constexpr size_t OFF_Z2 = OFF_BIG + (size_t)MT * 2048 * 2;

struct Args;
struct Args {
    const float* in[16];
    float* out;
    unsigned char* ws;
    int ph_lo, ph_hi;
};
#define AS4 __attribute__((address_space(4)))
typedef const AS4 Args* KP;

typedef __bf16 bf16x2_t __attribute__((ext_vector_type(2)));
typedef float f32x2_t __attribute__((ext_vector_type(2)));
__device__ __forceinline__ unsigned cvt_pk_bf16(float lo, float hi) { f32x2_t f = {lo, hi}; bf16x2_t v = __builtin_convertvector(f, bf16x2_t); return __builtin_bit_cast(unsigned, v); }
__device__ __forceinline__ bf16_t f2bf(float f) { return (bf16_t)(cvt_pk_bf16(f, 0.f) & 0xffffu); }
__device__ __forceinline__ float bf2f(bf16_t v) { return __uint_as_float((unsigned)v << 16); }
__device__ __forceinline__ float bflo(unsigned w) { return __uint_as_float(w << 16); }
__device__ __forceinline__ float bfhi(unsigned w) { return __uint_as_float(w & 0xffff0000u); }
__device__ __forceinline__ float wave_sum(float v) {
#pragma unroll
    for (int o = 1; o < 64; o <<= 1) v += __shfl_xor(v, o);
    return v;
}
__device__ __forceinline__ float silu_f(float g) { return g * __builtin_amdgcn_rcpf(1.f + __expf(-g)); }
__device__ __forceinline__ float clampf(float x, float lo, float hi) { return fminf(fmaxf(x, lo), hi); }
typedef unsigned u32x3 __attribute__((ext_vector_type(3)));
typedef unsigned u32x3a __attribute__((ext_vector_type(3), aligned(4)));
__device__ __forceinline__ unsigned f24(float f) { const unsigned u = __float_as_uint(f); return (u + 0x7Fu + ((u >> 8) & 1u)) >> 8; }
__device__ __forceinline__ u32x3 pack24(const f32x4 v) { const unsigned a0 = f24(v[0]), a1 = f24(v[1]), a2 = f24(v[2]), a3 = f24(v[3]);
    u32x3 d; d.x = a0 | (a1 << 24); d.y = (a1 >> 8) | (a2 << 16); d.z = (a2 >> 16) | (a3 << 8); return d; }
__device__ __forceinline__ f32x4 unpack24(const u32x3 d) { f32x4 v;
    v[0] = __uint_as_float(d.x << 8); v[1] = __uint_as_float(((d.x >> 24) | (d.y << 8)) << 8); v[2] = __uint_as_float(((d.y >> 16) | (d.z << 16)) << 8); v[3] = __uint_as_float(d.z & 0xFFFFFF00u); return v; }
__device__ __forceinline__ unsigned char* x24_row(unsigned char* ws, int row) { return row < X24_R1 ? ws + OFF_E + (size_t)row * 3072 : ws + OFF_X2 + (size_t)(row - X24_R1) * 3072; }

namespace pg8 {
constexpr int BM = 256, BK = 64, HALF = 128, HTB = HALF * BK * 2, NXCD = 8, WGM = 8;
__host__ __device__ __forceinline__ int lds_byte(int r, int c) { const int st = (r >> 4) * 2 + (c >> 5), rr = r & 15, cc = c & 31, ob = rr * 64 + cc * 2; return st * 1024 + (ob ^ (((ob >> 9) & 1) << 5)); }
__host__ __device__ __forceinline__ void stage_rc(int b, int& R, int& C) { const int st = b / 1024, sb = b % 1024, swz = sb ^ (((sb >> 9) & 1) << 5); R = (st >> 1) * 16 + swz / 64; C = (st & 1) * 32 + (swz % 64) / 2; }
__host__ __device__ __forceinline__ int perm32(int rho) { const int n = rho >> 4, i = rho & 15; return 8 * (i >> 2) + 4 * n + (i & 3); }

struct Unit { int pm, pn; };
struct Gemm { const bf16_t* A; const bf16_t* Bt; int M, N, K, lda, ldb, grpN, splitk; };
__device__ __forceinline__ int sk_off(int q) { return q < 2 ? q * 768 : 1536 + (q - 2) * 640; }
__device__ __forceinline__ int sk_len(int q) { return q < 2 ? 768 : 640; }

struct StaticOrder {
    int nM, nN, nwg, G, c;
    __device__ void init(int M, int N, int G_, int c_) { nM = M / BM; nN = N / BM; nwg = nM * nN; G = G_; c = c_; }
    __device__ bool next(int i, Unit& u) const {
        const long L = (long)i * G + c; if (L >= nwg) return false;
        int wgid = (int)L; { const int q = nwg / NXCD, r = nwg % NXCD, xcd = wgid % NXCD, off = wgid / NXCD; wgid = (xcd < r ? xcd * (q + 1) : r * (q + 1) + (xcd - r) * q) + off; }
        const int nig = WGM * nN, gid = wgid / nig, fm = gid * WGM, gsz = (nM - fm) < WGM ? (nM - fm) : WGM;
        u.pm = fm + ((wgid % nig) % gsz); u.pn = (wgid % nig) / gsz; return true;
    }
};

struct EpiF32 {
    static constexpr bool PERM = false;
    float* C; int ldc;
    __device__ __forceinline__ void operator()(const f32x4 (&acc)[2][2][4][2], const Unit& u, int wr, int wc, int fr, int fq, bool stream) const {
        const int row0 = u.pm * BM + wr * 64 + fr, col0 = u.pn * BM + wc * 32 + 4 * fq;
#pragma unroll
        for (int ai = 0; ai < 2; ++ai)
#pragma unroll
            for (int m = 0; m < 4; ++m) { float* rowp = C + (size_t)(row0 + ai * HALF + m * 16) * ldc + col0;
#pragma unroll
                for (int bj = 0; bj < 2; ++bj)
#pragma unroll
                    for (int n = 0; n < 2; ++n) *(f32x4*)(rowp + bj * HALF + n * 16) = acc[ai][bj][m][n]; }
    }
};
struct EpiBf16 {
    static constexpr bool PERM = true;
    bf16_t* O; int ldc; int act_lo_end, act_hi_start;
    __device__ __forceinline__ void operator()(const f32x4 (&acc)[2][2][4][2], const Unit& u, int wr, int wc, int fr, int fq, bool stream) const {
        const int row0 = u.pm * BM + wr * 64 + fr, col0 = u.pn * BM + wc * 32 + 8 * fq;
        const bool act = (u.pn * BM < act_lo_end) || (u.pn * BM >= act_hi_start);
#pragma unroll
        for (int ai = 0; ai < 2; ++ai)
#pragma unroll
            for (int m = 0; m < 4; ++m) { bf16_t* rowp = O + (size_t)(row0 + ai * HALF + m * 16) * ldc + col0;
#pragma unroll
                for (int bj = 0; bj < 2; ++bj) { f32x4 v0 = acc[ai][bj][m][0], v1 = acc[ai][bj][m][1];
                    if (act) {
#pragma unroll
                        for (int e = 0; e < 4; ++e) { v0[e] = silu_f(v0[e]); v1[e] = silu_f(v1[e]); } }
                    u32x4 w; w.x = cvt_pk_bf16(v0[0], v0[1]); w.y = cvt_pk_bf16(v0[2], v0[3]); w.z = cvt_pk_bf16(v1[0], v1[1]); w.w = cvt_pk_bf16(v1[2], v1[3]);
                    if (stream) __builtin_nontemporal_store(w, (u32x4*)(rowp + bj * HALF)); else *(u32x4*)(rowp + bj * HALF) = w; } }
    }
};
struct EpiSwiglu {
    static constexpr bool PERM = true;
    bf16_t* O; int ldc;
    __device__ __forceinline__ void operator()(const f32x4 (&acc)[2][2][4][2], const Unit& u, int wr, int wc, int fr, int fq, bool stream) const {
        const int row0 = u.pm * BM + wr * 64 + fr, col0 = u.pn * HALF + wc * 32 + 8 * fq;
#pragma unroll
        for (int ai = 0; ai < 2; ++ai)
#pragma unroll
            for (int m = 0; m < 4; ++m) { bf16_t* rowp = O + (size_t)(row0 + ai * HALF + m * 16) * ldc + col0;
                const f32x4 g0 = acc[ai][0][m][0], g1 = acc[ai][0][m][1], u0 = acc[ai][1][m][0], u1 = acc[ai][1][m][1];
                u32x4 w;
                w.x = cvt_pk_bf16(silu_f(g0[0]) * u0[0], silu_f(g0[1]) * u0[1]); w.y = cvt_pk_bf16(silu_f(g0[2]) * u0[2], silu_f(g0[3]) * u0[3]);
                w.z = cvt_pk_bf16(silu_f(g1[0]) * u1[0], silu_f(g1[1]) * u1[1]); w.w = cvt_pk_bf16(silu_f(g1[2]) * u1[2], silu_f(g1[3]) * u1[3]);
                if (stream) __builtin_nontemporal_store(w, (u32x4*)rowp); else *(u32x4*)rowp = w; }
    }
};

template <class Epi>
__device__ __forceinline__ void gemm_phase(LAS unsigned char* lds, const Gemm g, const StaticOrder& S, const Epi& E, const int TID) {
    const int tid = TID, wid = __builtin_amdgcn_readfirstlane(tid >> 6), lane = tid & 63, wr = wid >> 2, wc = wid & 3, fr = lane & 15, fq = lane >> 4;
    const int K = g.K, nt = K / BK;
    unsigned voffA[2], voffB[2];
#pragma unroll
    for (int i = 0; i < 2; ++i) { int R, C; stage_rc(tid * 16 + i * 8192, R, C); const int Rb = Epi::PERM ? ((R & ~31) + perm32(R & 31)) : R;
        voffA[i] = (unsigned)(R * g.lda + C) * 2u; voffB[i] = (unsigned)(Rb * g.ldb + C) * 2u; }
    const size_t kstep = (size_t)(BK * 2);
    const size_t hA = (size_t)HALF * g.lda * 2, hB = (size_t)HALF * g.ldb * 2;
    const unsigned ldsw = (unsigned)wid * 1024u;
    const int aoff = lds_byte(wr * 64 + fr, fq * 8), boff = lds_byte(wc * 32 + fr, fq * 8);
#define PG8_UA(u) ((const char*)g.A + (size_t)(u).pm * 2 * hA + (g.splitk ? (size_t)sk_off((u).pn / g.grpN) * 2 : (g.grpN ? (size_t)((u).pn / g.grpN) * K * 2 : (size_t)0)))
#define PG8_UB(u) ((const char*)g.Bt + (size_t)(g.grpN ? (u).pn % g.grpN : (u).pn) * 2 * hB + (g.splitk ? (size_t)sk_off((u).pn / g.grpN) * 2 : (size_t)0))
#define PG8_SA(b, h) (((b) * 2 + (h)) * HTB)
#define PG8_SB(b, h) ((4 + (b) * 2 + (h)) * HTB)
#define PG8_STAGE(bufoff, gbase, voff) do { _Pragma("unroll") for (int _i = 0; _i < 2; ++_i) \
        __builtin_amdgcn_global_load_lds((const unsigned*)((const char*)(gbase) + (voff)[_i]), (LAS unsigned*)(lds + (bufoff) + ldsw + _i * 8192), 16, 0, 0); } while (0)
#define PG8_LDA(dst, b, h) do { _Pragma("unroll") for (int m = 0; m < 4; ++m) _Pragma("unroll") for (int k = 0; k < 2; ++k) dst[m][k] = *(const LAS bf16x8*)(lds + PG8_SA(b, h) + aoff + m * 2048 + k * 1024); } while (0)
#define PG8_LDB(dst, b, h) do { _Pragma("unroll") for (int n = 0; n < 2; ++n) _Pragma("unroll") for (int k = 0; k < 2; ++k) dst[n][k] = *(const LAS bf16x8*)(lds + PG8_SB(b, h) + boff + n * 2048 + k * 1024); } while (0)
#define PG8_MMA(ai, bj, At, Bt) do { __builtin_amdgcn_s_setprio(1); _Pragma("unroll") for (int m = 0; m < 4; ++m) _Pragma("unroll") for (int n = 0; n < 2; ++n) _Pragma("unroll") for (int k = 0; k < 2; ++k) \
        acc[ai][bj][m][n] = __builtin_amdgcn_mfma_f32_16x16x32_bf16(Bt[n][k], At[m][k], acc[ai][bj][m][n], 0, 0, 0); __builtin_amdgcn_s_setprio(0); } while (0)
#define PG8_WAIT_V(n) asm volatile("s_waitcnt vmcnt(" #n ")" ::: "memory")
#define PG8_WAIT_L(n) asm volatile("s_waitcnt lgkmcnt(" #n ")" ::: "memory")
#define PG8_BAR __builtin_amdgcn_s_barrier()
#define PG8_SCHED __builtin_amdgcn_sched_barrier(0)
    Unit cur, nxt; int ui = 0;
    if (!S.next(0, cur)) return;
    f32x4 acc[2][2][4][2];
#pragma unroll
    for (int a = 0; a < 2; ++a)
#pragma unroll
        for (int b = 0; b < 2; ++b)
#pragma unroll
            for (int m = 0; m < 4; ++m)
#pragma unroll
                for (int n = 0; n < 2; ++n) acc[a][b][m][n] = (f32x4){0.f, 0.f, 0.f, 0.f};
    bf16x8 At[4][2], B0[2][2], B1[2][2];
    const char* cA = PG8_UA(cur); const char* cB = PG8_UB(cur);
    PG8_STAGE(PG8_SB(0, 0), cB, voffB); PG8_STAGE(PG8_SB(0, 1), cB + hB, voffB); PG8_STAGE(PG8_SA(0, 0), cA, voffA); PG8_STAGE(PG8_SA(0, 1), cA + hA, voffA);
    if (wr == 1) PG8_BAR;
    PG8_WAIT_V(2); PG8_BAR;
    PG8_STAGE(PG8_SB(1, 0), cB + kstep, voffB); PG8_STAGE(PG8_SA(1, 0), cA + kstep, voffA); PG8_STAGE(PG8_SB(1, 1), cB + hB + kstep, voffB);
    PG8_WAIT_V(6); PG8_BAR;
    for (;;) {
        const bool has_next = S.next(ui + 1, nxt);
        const char* nA = has_next ? PG8_UA(nxt) : cA; const char* nB = has_next ? PG8_UB(nxt) : cB;
        for (int t = 0; t < nt; t += 2) {
            const bool last = (t == nt - 2);
            const char* a1 = cA + (size_t)(t + 1) * kstep;
            const char* a2 = last ? nA : cA + (size_t)(t + 2) * kstep; const char* b2 = last ? nB : cB + (size_t)(t + 2) * kstep;
            const char* a3 = a2 + kstep; const char* b3 = b2 + kstep;
            PG8_LDB(B0, 0, 0); PG8_LDB(B1, 0, 1); PG8_SCHED; PG8_LDA(At, 0, 0); PG8_STAGE(PG8_SA(1, 1), a1 + hA, voffA);
            PG8_WAIT_V(8); PG8_WAIT_L(0); PG8_BAR; PG8_MMA(0, 0, At, B0); PG8_MMA(0, 1, At, B1); PG8_BAR; PG8_SCHED;
            PG8_LDA(At, 0, 1); PG8_STAGE(PG8_SB(0, 0), b2, voffB); PG8_STAGE(PG8_SB(0, 1), b2 + hB, voffB); PG8_STAGE(PG8_SA(0, 0), a2, voffA);
            PG8_WAIT_V(8); PG8_WAIT_L(0); PG8_BAR; PG8_MMA(1, 0, At, B0); PG8_MMA(1, 1, At, B1); PG8_BAR; PG8_SCHED;
            PG8_LDB(B0, 1, 0); PG8_LDB(B1, 1, 1); PG8_SCHED; PG8_LDA(At, 1, 0); PG8_STAGE(PG8_SA(0, 1), a2 + hA, voffA);
            PG8_WAIT_V(8); PG8_WAIT_L(0); PG8_BAR; PG8_MMA(0, 0, At, B0); PG8_MMA(0, 1, At, B1); PG8_BAR; PG8_SCHED;
            PG8_LDA(At, 1, 1); PG8_STAGE(PG8_SB(1, 0), b3, voffB); PG8_STAGE(PG8_SB(1, 1), b3 + hB, voffB); PG8_STAGE(PG8_SA(1, 0), a3, voffA);
            PG8_WAIT_V(8); PG8_WAIT_L(0); PG8_BAR; PG8_MMA(1, 0, At, B0); PG8_MMA(1, 1, At, B1); PG8_BAR; PG8_SCHED;
        }
        if (wr == 0) PG8_BAR;
        E(acc, cur, wr, wc, fr, fq, !has_next);
        if (!has_next) break;
#pragma unroll
        for (int a = 0; a < 2; ++a)
#pragma unroll
            for (int b = 0; b < 2; ++b)
#pragma unroll
                for (int m = 0; m < 4; ++m)
#pragma unroll
                    for (int n = 0; n < 2; ++n) acc[a][b][m][n] = (f32x4){0.f, 0.f, 0.f, 0.f};
        cur = nxt; cA = nA; cB = nB; ++ui;
        if (wr == 1) PG8_BAR;
    }
    PG8_WAIT_V(0);
    PG8_BAR;
#undef PG8_UA
#undef PG8_UB
#undef PG8_SA
#undef PG8_SB
#undef PG8_STAGE
#undef PG8_LDA
#undef PG8_LDB
#undef PG8_MMA
#undef PG8_WAIT_V
#undef PG8_WAIT_L
#undef PG8_BAR
#undef PG8_SCHED
}
}

__device__ __forceinline__ int maprow_glu(int n) { return n < DFF ? (n >> 7) * 256 + (n & 127) : ((n - DFF) >> 7) * 256 + 128 + ((n - DFF) & 127); }

struct TrItem { const float* W; bf16_t* WT; int K, N, item; bool glu; };
__device__ __forceinline__ void tr_load(const TrItem& t, float (&v)[32], int lane) {
    const int nblk = t.N / 32, kb = t.item / nblk, nb = t.item % nblk, k0 = 64 * kb, n0 = 32 * nb;
    const float* p = t.W + (size_t)(k0 + (lane >> 5)) * t.N + n0 + (lane & 31);
#pragma unroll
    for (int i = 0; i < 32; ++i) v[i] = __builtin_nontemporal_load(p + (size_t)(2 * i) * t.N);
}
__device__ __forceinline__ void tr_store(const TrItem& t, const float (&v)[32], LAS float* scr, int lane) {
    const int nblk = t.N / 32, kb = t.item / nblk, nb = t.item % nblk, k0 = 64 * kb, n0 = 32 * nb;
#pragma unroll
    for (int i = 0; i < 32; ++i) scr[(2 * i + (lane >> 5)) * 33 + (lane & 31)] = v[i];
    asm volatile("s_waitcnt lgkmcnt(0)" ::: "memory");
    const int c = lane & 7;
#pragma unroll
    for (int j = 0; j < 4; ++j) { const int n = (lane >> 3) + 8 * j; const LAS float* sp = scr + (8 * c) * 33 + n;
        u32x4 o; o.x = cvt_pk_bf16(sp[0 * 33], sp[1 * 33]); o.y = cvt_pk_bf16(sp[2 * 33], sp[3 * 33]); o.z = cvt_pk_bf16(sp[4 * 33], sp[5 * 33]); o.w = cvt_pk_bf16(sp[6 * 33], sp[7 * 33]);
        const int drow = t.glu ? maprow_glu(n0 + n) : n0 + n;
        *(u32x4*)(t.WT + (size_t)drow * t.K + k0 + 8 * c) = o; }
    asm volatile("s_waitcnt lgkmcnt(0)" ::: "memory");
}

__device__ __forceinline__ void dft_table(bf16_t* W, int NTOK, int M, float scale, int gtid, int gthreads, bool realin) {
    const int K = realin ? NTOK : 2 * NTOK;
    for (int idx = gtid; idx < M * K; idx += gthreads) {
        const int m = idx / K, k = idx % K, po = m / NTOK, F = m % NTOK, pi = k / NTOK, t = k % NTOK;
        const int ii = (F * t) % NTOK; const float x = 2.0f * (float)ii / (float)NTOK;
        const float cs = cospif(x), sn = sinpif(x);
        const float v = po == 0 ? (pi == 0 ? cs : -sn) : (pi == 0 ? sn : cs);
        W[idx] = f2bf(v * scale);
    }
}

__device__ __forceinline__ void phase_prologue(KP a, LAS unsigned char* lds, const int TID, const int BID, const int NBLK, int parts) {
    const int tid = TID, wid = tid >> 6, lane = tid & 63;
    if (parts & 1)
    {
        LAS float* sS = (LAS float*)lds;
        LAS float* red = (LAS float*)(lds + 36864);
        for (int idx = tid; idx < 9 * 1024; idx += 512) { const int r = idx >> 10, k = idx & 1023; const float cv = r < 8 ? a->in[1][r * 1024 + k] : a->in[3][k]; sS[idx] = cv / (1.f + __expf(-cv)); }
        __syncthreads();
        float* MOD = (float*)(a->ws + OFF_MOD);
        for (int item = BID; item < 4 * 36; item += NBLK) {
            const int L = item / 36, n0 = (item % 36) * 256;
            const float* w = a->in[4] + ((size_t)L * 1024 + wid * 128) * 9216 + n0 + 4 * lane;
            f32x4 acc[9];
#pragma unroll
            for (int r = 0; r < 9; ++r) acc[r] = (f32x4){0.f, 0.f, 0.f, 0.f};
            for (int kb = 0; kb < 128; kb += 16) { f32x4 wv[16];
#pragma unroll
                for (int u = 0; u < 16; ++u) wv[u] = __builtin_nontemporal_load((const f32x4*)(w + (size_t)(kb + u) * 9216));
#pragma unroll
                for (int u = 0; u < 16; ++u)
#pragma unroll
                    for (int r = 0; r < 9; ++r) acc[r] = acc[r] + wv[u] * sS[r * 1024 + wid * 128 + kb + u]; }
            LAS f32x4* red4 = (LAS f32x4*)(lds + 36864);
#pragma unroll
            for (int r = 0; r < 9; ++r) red4[(wid * 9 + r) * 64 + lane] = acc[r];
            __syncthreads();
            for (int idx = tid; idx < 9 * 64; idx += 512) { const int r = idx >> 6, cc = idx & 63;
                f32x4 sum = *(const f32x4*)(a->in[5] + L * 9216 + n0 + 4 * cc);
#pragma unroll
                for (int q = 0; q < 8; ++q) sum = sum + red4[(q * 9 + r) * 64 + cc];
                *(f32x4*)(MOD + ((size_t)L * 9 + r) * 9216 + n0 + 4 * cc) = sum; }
            __syncthreads();
        }
    }
    if (parts & 2) {
        const int gtid = BID * 512 + tid, gth = NBLK * 512;
        dft_table((bf16_t*)(a->ws + OFF_WD1), 256, 512, 1.f / 16.f, gtid, gth, true);
        dft_table((bf16_t*)(a->ws + OFF_W2X), 64, 128, 1.f / 8.f, gtid, gth, false);
        dft_table((bf16_t*)(a->ws + OFF_W3X), 64, 64, 1.f / 8.f, gtid, gth, false);
        dft_table((bf16_t*)(a->ws + OFF_WC), 256, 256, 1.f / 16.f, gtid, gth, false);
    }
    if (parts & 4) {
        LAS float* scr = (LAS float*)(lds + wid * 8448);
        const int gw = BID * 8 + wid, NW = NBLK * 8;
        constexpr int I_IN = 16 * 176, I_OUT = 44 * 32, I_SQ = 16 * 32, I_HIN = 16 * 160;
        constexpr int T0 = 8 * I_IN, T1 = T0 + 8 * I_OUT, T2 = T1 + 2 * I_SQ, T3 = T2 + 2 * I_HIN, T4 = T3 + 2 * I_SQ;
        auto decode = [&](int it, TrItem& t) {
            if (it < T0) { const int mi = it / I_IN; t.W = a->in[8] + (size_t)mi * 1024 * 5632; t.K = 1024; t.N = 5632; t.WT = (bf16_t*)(a->ws + OFF_WIN + mi * SZ_WIN1); t.item = it % I_IN; t.glu = true; }
            else if (it < T1) { const int r = it - T0, mi = r / I_OUT; t.W = a->in[9] + (size_t)mi * 2816 * 1024; t.K = 2816; t.N = 1024; t.WT = (bf16_t*)(a->ws + OFF_WOUT + mi * SZ_WOUT1); t.item = r % I_OUT; t.glu = false; }
            else if (it < T2) { const int r = it - T1, mi = r / I_SQ; t.W = a->in[10] + (size_t)mi * 1024 * 1024; t.K = 1024; t.N = 1024; t.WT = (bf16_t*)(a->ws + OFF_WFO + mi * SZ_SQ); t.item = r % I_SQ; t.glu = false; }
            else if (it < T3) { const int r = it - T2, mi = r / I_HIN; t.W = a->in[11] + (size_t)mi * 1024 * 5120; t.K = 1024; t.N = 5120; t.WT = (bf16_t*)(a->ws + OFF_WHIN + mi * SZ_WHIN1); t.item = r % I_HIN; t.glu = false; }
            else { const int r = it - T3, mi = r / I_SQ; t.W = a->in[15] + (size_t)mi * 1024 * 1024; t.K = 1024; t.N = 1024; t.WT = (bf16_t*)(a->ws + OFF_WHOUT + mi * SZ_SQ); t.item = r % I_SQ; t.glu = false; } };
        for (int it = gw; it < T4; it += NW) {
            TrItem t0; float v0[32];
            decode(it, t0); tr_load(t0, v0, lane);
            tr_store(t0, v0, scr, lane);
        }
    }
}

constexpr int EWR = 1;
__device__ __forceinline__ void phase_ew(KP a, int lpost, int jpost, float wpost, const bf16_t* Y, int lpre, int jpre, bool first, int M, const int TID, const int BID, const int NBLK, const bf16_t* YP = nullptr) {
    const int wid = TID >> 6, lane = TID & 63;
    const float* MOD = (const float*)(a->ws + OFF_MOD);
    const bool fin = lpre < 0;
    bf16_t* H = (bf16_t*)(a->ws + OFF_H);
    const int gw = BID * 8 + wid, NW = NBLK * 8, rpw = (M + NW - 1) / NW;
    const int rbeg = gw * rpw, rend = min(M, rbeg + rpw);
    int cur_mr = -1;
    f32x4 cg[4], cp[4], sh4[4];
#pragma unroll
    for (int j = 0; j < 4; ++j) { cg[j] = (f32x4){0.f, 0.f, 0.f, 0.f}; cp[j] = cg[j]; sh4[j] = cg[j]; }
    for (int rowb = rbeg; rowb < rend; rowb += EWR) {
        int rows[EWR]; bool ok[EWR];
#pragma unroll
        for (int u = 0; u < EWR; ++u) { rows[u] = rowb + u; ok[u] = rows[u] < rend; if (!ok[u]) rows[u] = rowb; }
        f32x4 xv[EWR][4]; u32x2 yr[EWR][4];
        unsigned char* xr[EWR]; int mr[EWR];
#pragma unroll
        for (int u = 0; u < EWR; ++u) { const int row = rows[u]; mr[u] = row < MX ? (row >> 12) : 8;
            xr[u] = x24_row(a->ws, row) + 12 * lane;
            if (first) { const float* xs = row < MX ? a->in[0] + (size_t)row * D : a->in[2] + (size_t)(row - MX) * D;
#pragma unroll
                for (int j = 0; j < 4; ++j) xv[u][j] = __builtin_nontemporal_load((const f32x4*)(xs + 4 * lane + 256 * j));
            } else {
#pragma unroll
                for (int j = 0; j < 4; ++j) xv[u][j] = unpack24(__builtin_nontemporal_load((const u32x3a*)(xr[u] + 768 * j))); }
            if (lpost >= 0) {
                if (YP != nullptr && row >= MX) {
#pragma unroll
                    for (int j = 0; j < 4; ++j) { float s0 = 0.f, s1 = 0.f, s2 = 0.f, s3 = 0.f;
#pragma unroll
                        for (int q = 0; q < 4; ++q) { const u32x2 w = *(const u32x2*)(YP + (size_t)(row - MX) * 4096 + q * 1024 + 4 * lane + 256 * j); s0 += bflo(w.x); s1 += bfhi(w.x); s2 += bflo(w.y); s3 += bfhi(w.y); }
                        yr[u][j].x = cvt_pk_bf16(s0, s1); yr[u][j].y = cvt_pk_bf16(s2, s3); }
                } else {
#pragma unroll
                    for (int j = 0; j < 4; ++j) yr[u][j] = __builtin_nontemporal_load((const u32x2*)(Y + (size_t)row * D + 4 * lane + 256 * j)); } } }
#pragma unroll
        for (int u = 0; u < EWR; ++u) {
            const int row = rows[u];
            if (mr[u] != cur_mr) {
                cur_mr = mr[u];
                if (lpost >= 0) { const float* gate = MOD + ((size_t)lpost * 9 + cur_mr) * 9216 + (3 * jpost + 2) * 1024; const float* gp = a->in[7] + (lpost * 3 + jpost) * 1024;
#pragma unroll
                    for (int j = 0; j < 4; ++j) cg[j] = *(const f32x4*)(gate + 4 * lane + 256 * j) * *(const f32x4*)(gp + 4 * lane + 256 * j); }
                if (lpre >= 0) { const float* sh = MOD + ((size_t)lpre * 9 + cur_mr) * 9216 + (3 * jpre) * 1024; const float* gp = a->in[6] + (lpre * 3 + jpre) * 1024;
#pragma unroll
                    for (int j = 0; j < 4; ++j) { sh4[j] = *(const f32x4*)(sh + 4 * lane + 256 * j); cp[j] = *(const f32x4*)(gp + 4 * lane + 256 * j) * (*(const f32x4*)(sh + 1024 + 4 * lane + 256 * j) + 1.f); } }
            }
            if (lpost >= 0) {
                f32x4 yv[4]; float ss = 0.f;
#pragma unroll
                for (int j = 0; j < 4; ++j) { yv[j] = (f32x4){bflo(yr[u][j].x), bfhi(yr[u][j].x), bflo(yr[u][j].y), bfhi(yr[u][j].y)}; ss += (yv[j][0] * yv[j][0] + yv[j][1] * yv[j][1]) + (yv[j][2] * yv[j][2] + yv[j][3] * yv[j][3]); }
                ss = wave_sum(ss);
                const float r = wpost * rsqrtf(ss * (1.f / D) + EPS);
#pragma unroll
                for (int j = 0; j < 4; ++j) xv[u][j] = xv[u][j] + (yv[j] * r) * cg[j];
            }
            if (ok[u]) {
                if (fin) {
#pragma unroll
                    for (int j = 0; j < 4; ++j) __builtin_nontemporal_store(xv[u][j], (f32x4*)(a->out + (size_t)row * D + 4 * lane + 256 * j));
                } else if (lpost >= 0 || first) {
#pragma unroll
                    for (int j = 0; j < 4; ++j) __builtin_nontemporal_store(pack24(xv[u][j]), (u32x3a*)(xr[u] + 768 * j));
                }
            }
            if (lpre >= 0 && ok[u]) {
                float ss = 0.f;
#pragma unroll
                for (int j = 0; j < 4; ++j) ss += (xv[u][j][0] * xv[u][j][0] + xv[u][j][1] * xv[u][j][1]) + (xv[u][j][2] * xv[u][j][2] + xv[u][j][3] * xv[u][j][3]);
                ss = wave_sum(ss);
                const float r = rsqrtf(ss * (1.f / D) + EPS);
#pragma unroll
                for (int j = 0; j < 4; ++j) { const f32x4 hv = (xv[u][j] * r) * cp[j] + sh4[j];
                    u32x2 w; w.x = cvt_pk_bf16(hv[0], hv[1]); w.y = cvt_pk_bf16(hv[2], hv[3]);
                    *(u32x2*)(H + (size_t)row * D + 4 * lane + 256 * j) = w; }
            }
        }
    }
}

template <int NTOK, int MPARTS>
__device__ __forceinline__ void token_stage(LAS unsigned char* lds, const bf16_t* Zin, bf16_t* Zout, const bf16_t* W, int nlines, int mode, const int TID, const int BID, const int NBLK) {
    constexpr int K = 2 * NTOK, M = MPARTS * NTOK, MTW = M / 32, KS = K / 32, OLD = MPARTS == 2 ? 2048 : 1024;
    LAS unsigned* T = (LAS unsigned*)lds;
    LAS bf16_t* T16 = (LAS bf16_t*)lds;
    const int tid = TID, wid = tid >> 6, lane = tid & 63, fr = lane & 15, fq = lane >> 4, nt = wid & 3, mh = wid >> 2;
    for (int item = BID; item < nlines * 16; item += NBLK) {
        const int l = item >> 4, cb = item & 15, g = cb >> 2, F0 = (cb & 3) * 64;
        int row0, rs;
        if (mode == 0) { row0 = (l >> 6) * 4096 + (l & 63) * 64; rs = 1; } else if (mode == 1) { row0 = (l >> 6) * 4096 + (l & 63); rs = 64; } else { row0 = MX + l * 256; rs = 1; }
        for (int idx = tid; idx < K * 8; idx += 512) { const int k = idx >> 3, c8 = idx & 7, part = k / NTOK, t = k % NTOK;
            const u32x4 v = *(const u32x4*)(Zin + (size_t)(row0 + t * rs) * 2048 + g * 512 + part * 256 + F0 + c8 * 8);
            LAS unsigned* d = T + k * 33 + c8 * 4; d[0] = v.x; d[1] = v.y; d[2] = v.z; d[3] = v.w; }
        __syncthreads();
        f32x4 acc[MTW];
#pragma unroll
        for (int i = 0; i < MTW; ++i) acc[i] = (f32x4){0.f, 0.f, 0.f, 0.f};
#pragma unroll 2
        for (int ks = 0; ks < KS; ++ks) {
            bf16x8 b;
#pragma unroll
            for (int j = 0; j < 8; ++j) b[j] = (short)T16[(ks * 32 + fq * 8 + j) * 66 + nt * 16 + fr];
#pragma unroll
            for (int i = 0; i < MTW; ++i) { const bf16x8 av = *(const bf16x8*)(W + (size_t)((mh * MTW + i) * 16 + fr) * K + ks * 32 + fq * 8);
                acc[i] = __builtin_amdgcn_mfma_f32_16x16x32_bf16(av, b, acc[i], 0, 0, 0); }
        }
        __syncthreads();
#pragma unroll
        for (int i = 0; i < MTW; ++i)
#pragma unroll
            for (int j = 0; j < 4; ++j) T16[((mh * MTW + i) * 16 + fq * 4 + j) * 66 + nt * 16 + fr] = f2bf(acc[i][j]);
        __syncthreads();
        for (int idx = tid; idx < M * 8; idx += 512) { const int m = idx >> 3, c8 = idx & 7, part = m / NTOK, F = m % NTOK;
            const LAS unsigned* s = T + m * 33 + c8 * 4; u32x4 v; v.x = s[0]; v.y = s[1]; v.z = s[2]; v.w = s[3];
            const int col = MPARTS == 2 ? g * 512 + part * 256 + F0 + c8 * 8 : g * 256 + F0 + c8 * 8;
            *(u32x4*)(Zout + (size_t)(row0 + F * rs) * OLD + col) = v; }
        __syncthreads();
    }
}

template <int MPARTS>
__device__ __forceinline__ void token_stage_x(LAS unsigned char* lds, const bf16_t* Zin, bf16_t* Zout, const bf16_t* W, int mode, const int TID, const int BID, const int NBLK) {
    constexpr int NTOK = 64, K = 128, M = MPARTS * NTOK, MTW = M / 32, KS = 4, OLD = MPARTS == 2 ? 2048 : 1024, TB = K * 33 * 4;
    const int tid = TID, wid = tid >> 6, lane = tid & 63, fr = lane & 15, fq = lane >> 4, nt = wid & 3, mh = wid >> 2;
    LAS unsigned* OT = (LAS unsigned*)(lds + 2 * TB);
    LAS bf16_t* OT16 = (LAS bf16_t*)(lds + 2 * TB);
    bf16x8 wf[MTW][KS];
#pragma unroll
    for (int i = 0; i < MTW; ++i)
#pragma unroll
        for (int ks = 0; ks < KS; ++ks) wf[i][ks] = *(const bf16x8*)(W + (size_t)((mh * MTW + i) * 16 + fr) * K + ks * 32 + fq * 8);
    const int nitems = 512 * 16;
    const int k0 = tid >> 3, k1 = k0 + 64, c8 = tid & 7;
    u32x4 r0v, r1v;
    auto item_rows = [&](int item, int& row0, int& rs, int& colb) { const int l = item >> 4, cb = item & 15, g = cb >> 2, F0 = (cb & 3) * 64;
        if (mode == 0) { row0 = (l >> 6) * 4096 + (l & 63) * 64; rs = 1; } else { row0 = (l >> 6) * 4096 + (l & 63); rs = 64; }
        colb = g * 512 + F0; };
    int item = BID;
    if (item < nitems) { int row0, rs, colb; item_rows(item, row0, rs, colb);
        const bf16_t* src = Zin + (size_t)(row0 + k0 * rs) * 2048 + colb + c8 * 8; r0v = __builtin_nontemporal_load((const u32x4*)src); r1v = __builtin_nontemporal_load((const u32x4*)(src + 256)); }
    int cur = 0;
    if (item < nitems) { LAS unsigned* T = (LAS unsigned*)(lds + cur * TB); LAS unsigned* d0 = T + k0 * 33 + c8 * 4; LAS unsigned* d1 = T + k1 * 33 + c8 * 4;
        d0[0] = r0v.x; d0[1] = r0v.y; d0[2] = r0v.z; d0[3] = r0v.w; d1[0] = r1v.x; d1[1] = r1v.y; d1[2] = r1v.z; d1[3] = r1v.w; }
    { const int nx = item + NBLK; if (nx < nitems) { int row0, rs, colb; item_rows(nx, row0, rs, colb);
        const bf16_t* src = Zin + (size_t)(row0 + k0 * rs) * 2048 + colb + c8 * 8; r0v = __builtin_nontemporal_load((const u32x4*)src); r1v = __builtin_nontemporal_load((const u32x4*)(src + 256)); } }
    for (; item < nitems; item += NBLK) {
        int row0, rs, colb; item_rows(item, row0, rs, colb);
        const LAS bf16_t* T16 = (const LAS bf16_t*)(lds + cur * TB);
        __syncthreads();
        f32x4 acc[MTW];
#pragma unroll
        for (int i = 0; i < MTW; ++i) acc[i] = (f32x4){0.f, 0.f, 0.f, 0.f};
#pragma unroll
        for (int ks = 0; ks < KS; ++ks) {
            bf16x8 b;
#pragma unroll
            for (int j = 0; j < 8; ++j) b[j] = (short)T16[(ks * 32 + fq * 8 + j) * 66 + nt * 16 + fr];
#pragma unroll
            for (int i = 0; i < MTW; ++i) acc[i] = __builtin_amdgcn_mfma_f32_16x16x32_bf16(wf[i][ks], b, acc[i], 0, 0, 0);
        }
#pragma unroll
        for (int i = 0; i < MTW; ++i)
#pragma unroll
            for (int j = 0; j < 4; ++j) OT16[((mh * MTW + i) * 16 + fq * 4 + j) * 66 + nt * 16 + fr] = f2bf(acc[i][j]);
        if (item + NBLK < nitems) {
            LAS unsigned* T = (LAS unsigned*)(lds + (cur ^ 1) * TB); LAS unsigned* d0 = T + k0 * 33 + c8 * 4; LAS unsigned* d1 = T + k1 * 33 + c8 * 4;
            d0[0] = r0v.x; d0[1] = r0v.y; d0[2] = r0v.z; d0[3] = r0v.w; d1[0] = r1v.x; d1[1] = r1v.y; d1[2] = r1v.z; d1[3] = r1v.w;
            const int nx = item + 2 * NBLK;
            if (nx < nitems) { int row0n, rsn, colbn; item_rows(nx, row0n, rsn, colbn);
                const bf16_t* src = Zin + (size_t)(row0n + k0 * rsn) * 2048 + colbn + c8 * 8; r0v = __builtin_nontemporal_load((const u32x4*)src); r1v = __builtin_nontemporal_load((const u32x4*)(src + 256)); }
        }
        __syncthreads();
        for (int idx = tid; idx < M * 8; idx += 512) { const int m = idx >> 3, cc = idx & 7, part = m / NTOK, F = m % NTOK;
            const LAS unsigned* sp = OT + m * 33 + cc * 4; u32x4 v; v.x = sp[0]; v.y = sp[1]; v.z = sp[2]; v.w = sp[3];
            const int col = MPARTS == 2 ? colb + part * 256 + cc * 8 : (colb >> 9) * 256 + (colb & 511) + cc * 8;
            *(u32x4*)(Zout + (size_t)(row0 + F * rs) * OLD + col) = v; }
        cur ^= 1;
    }
    __syncthreads();
}

__device__ __forceinline__ void phase_scan(KP a, LAS unsigned char* lds, int jm, const int TID, const int BID, const int NBLK) {
    const bf16_t* P = (const bf16_t*)(a->ws + OFF_BIG);
    const int tid = TID, wid = tid >> 6, lane = tid & 63, fr = lane & 15, fq = lane >> 4;
    LAS bf16_t* Qt = (LAS bf16_t*)lds;
    LAS bf16_t* Kt = (LAS bf16_t*)(lds + 17408);
    LAS bf16_t* KtT = (LAS bf16_t*)(lds + 34816);
    LAS bf16_t* VtT = (LAS bf16_t*)(lds + 53248);
    LAS bf16_t* At = (LAS bf16_t*)(lds + 62464);
    LAS bf16_t* SpT = (LAS bf16_t*)(lds + 71680);
    LAS float* em = (LAS float*)(lds + 89088);
    LAS float* el = em + 128;
    LAS float* elm = em + 256;
    LAS float* segtot = (LAS float*)(lds + 90624);
    for (int item = BID; item < 256; item += NBLK) {
        const int dvh = item & 1, dir = (item >> 1) & 1, h = (item >> 2) & 7, b = item >> 5;
        const int k = tid & 127, sg = __builtin_amdgcn_readfirstlane(tid >> 7);
        const float* lbl = dir ? a->in[13] : a->in[12];
        float lbv = 0.f;
        if (jm) { const float a0 = lbl[h * 128 + k], a1 = lbl[1024 + h * 128 + k]; lbv = 1.f / (1.f + __expf(a0 - a1)); }
        const float lbm = fmaxf(lbv, 1e-30f), oml = 1.f - lbv;
        f32x4 S[4];
#pragma unroll
        for (int i = 0; i < 4; ++i) S[i] = (f32x4){0.f, 0.f, 0.f, 0.f};
        const int dvl = tid & 63, ssg = __builtin_amdgcn_readfirstlane(tid >> 6);
        const unsigned cz = 2048 + dir * 1024 + h * 128 + k, cq = h * 128 + k, cv = 1024 + h * 128 + dvh * 64 + dvl;
        bf16_t* Op = (dir ? (bf16_t*)a->out : (bf16_t*)(a->ws + OFF_H)) + h * 128 + dvh * 64;
        const int mt = wid >> 1, n0 = (wid & 1) * 2;
        const int rs = dir ? -1 : 1;
        unsigned zr[16], qr[16], vr[8];
        {
            const int r0 = dir ? MX + b * 256 + 255 : MX + b * 256;
#pragma unroll
            for (int i = 0; i < 16; ++i) { const bf16_t* pr = P + (size_t)(r0 + (16 * sg + i) * rs) * NPROJ; zr[i] = pr[cz]; qr[i] = pr[cq]; }
#pragma unroll
            for (int i = 0; i < 8; ++i) vr[i] = (P + (size_t)(r0 + (8 * ssg + i) * rs) * NPROJ)[cv];
        }
        for (int c = 0; c < 68; ++c) {
            int r0;
            { int base, len, cc; if (c < 4) { base = MX + b * 256; len = 256; cc = c; } else { base = b * 4096; len = 4096; cc = c - 4; }
              r0 = dir ? base + len - 1 - cc * 64 : base + cc * 64; }
            float f[16], kr[16], qs[16];
#pragma unroll
            for (int i = 0; i < 16; ++i) { const float z = clampf(__uint_as_float(zr[i] << 16), -30.f, 30.f);
                const float e = __expf(-z), sig = __builtin_amdgcn_rcpf(1.f + e);
                f[i] = lbm + oml * sig; kr[i] = oml * e * sig; qs[i] = __uint_as_float(qr[i] << 16); }
            u32x4 vp; vp.x = vr[0] | (vr[1] << 16); vp.y = vr[2] | (vr[3] << 16); vp.z = vr[4] | (vr[5] << 16); vp.w = vr[6] | (vr[7] << 16);
            if (c + 1 < 68) {
                const int cn = c + 1; int base, len, cc; if (cn < 4) { base = MX + b * 256; len = 256; cc = cn; } else { base = b * 4096; len = 4096; cc = cn - 4; }
                const int rn = dir ? base + len - 1 - cc * 64 : base + cc * 64;
#pragma unroll
                for (int i = 0; i < 16; ++i) { const bf16_t* pr = P + (size_t)(rn + (16 * sg + i) * rs) * NPROJ; zr[i] = pr[cz]; qr[i] = pr[cq]; }
#pragma unroll
                for (int i = 0; i < 8; ++i) vr[i] = (P + (size_t)(rn + (8 * ssg + i) * rs) * NPROJ)[cv];
            }
            float g[16], T;
            if (sg < 2) { float run = 1.f;
#pragma unroll
                for (int i = 15; i >= 0; --i) { g[i] = run; run *= f[i]; }
                T = run;
            } else { float run = 1.f;
#pragma unroll
                for (int i = 0; i < 16; ++i) { run *= f[i]; g[i] = run; }
                T = run; }
            LAS float* st = segtot + (c & 1) * 512;
            st[sg * 128 + k] = T;
            __syncthreads();
            {
                const float t0 = st[k], t1 = st[128 + k], t2 = st[256 + k], t3 = st[384 + k];
                const float mult = sg == 0 ? t1 : (sg == 3 ? t2 : 1.f);
                const bool firsthalf = sg < 2;
                unsigned kp[8];
#pragma unroll
                for (int i = 0; i < 16; i += 2) {
                    const float G0 = fmaxf(g[i] * mult, 1e-30f), G1 = fmaxf(g[i + 1] * mult, 1e-30f);
                    const float R0 = __builtin_amdgcn_rcpf(G0), R1 = __builtin_amdgcn_rcpf(G1);
                    const float q0 = qs[i] * (firsthalf ? R0 : G0), q1 = qs[i + 1] * (firsthalf ? R1 : G1);
                    const float k0 = kr[i] * (firsthalf ? G0 : R0), k1 = kr[i + 1] * (firsthalf ? G1 : R1);
                    const unsigned qw = cvt_pk_bf16(q0, q1), kw = cvt_pk_bf16(k0, k1);
                    const int tau = 16 * sg + i;
                    Qt[tau * 136 + k] = (bf16_t)(qw & 0xffffu); Qt[(tau + 1) * 136 + k] = (bf16_t)(qw >> 16);
                    Kt[tau * 136 + k] = (bf16_t)(kw & 0xffffu); Kt[(tau + 1) * 136 + k] = (bf16_t)(kw >> 16);
                    kp[i >> 1] = kw;
                }
                *(LAS u32x4*)(KtT + k * 72 + 16 * sg) = (u32x4){kp[0], kp[1], kp[2], kp[3]};
                *(LAS u32x4*)(KtT + k * 72 + 16 * sg + 8) = (u32x4){kp[4], kp[5], kp[6], kp[7]};
                if (sg == 0) { const float m_ = t0 * t1, lm_ = t2 * t3; em[k] = m_; elm[k] = lm_; el[k] = m_ * lm_; }
                *(LAS u32x4*)(VtT + dvl * 72 + 8 * ssg) = vp;
            }
            __syncthreads();
            {
                const f32x4 e4 = *(const LAS f32x4*)(em + 16 * wid + 4 * fq);
#pragma unroll
                for (int n = 0; n < 4; ++n) { const f32x4 v = S[n] * e4; u32x2 w; w.x = cvt_pk_bf16(v[0], v[1]); w.y = cvt_pk_bf16(v[2], v[3]);
                    *(LAS u32x2*)(SpT + (16 * n + fr) * 136 + 16 * wid + 4 * fq) = w; }
            }
            {
                f32x4 c0 = (f32x4){0.f, 0.f, 0.f, 0.f}, c1 = c0;
#pragma unroll
                for (int ks = 0; ks < 4; ++ks) {
                    const bf16x8 av = *(const LAS bf16x8*)(Qt + (16 * mt + fr) * 136 + 32 * ks + 8 * fq);
                    const bf16x8 b0 = *(const LAS bf16x8*)(Kt + (16 * n0 + fr) * 136 + 32 * ks + 8 * fq);
                    const bf16x8 b1 = *(const LAS bf16x8*)(Kt + (16 * (n0 + 1) + fr) * 136 + 32 * ks + 8 * fq);
                    c0 = __builtin_amdgcn_mfma_f32_16x16x32_bf16(av, b0, c0, 0, 0, 0);
                    c1 = __builtin_amdgcn_mfma_f32_16x16x32_bf16(av, b1, c1, 0, 0, 0);
                }
#pragma unroll
                for (int j = 0; j < 4; ++j) { const int t = 16 * mt + 4 * fq + j, s0 = 16 * n0 + fr, s1 = s0 + 16;
                    At[t * 72 + s0] = f2bf(s0 <= t ? c0[j] : 0.f); At[t * 72 + s1] = f2bf(s1 <= t ? c1[j] : 0.f); }
            }
            __syncthreads();
            {
                f32x4 o0 = (f32x4){0.f, 0.f, 0.f, 0.f}, o1 = o0;
#pragma unroll
                for (int ks = 0; ks < 2; ++ks) {
                    const bf16x8 av = *(const LAS bf16x8*)(At + (16 * mt + fr) * 72 + 32 * ks + 8 * fq);
                    const bf16x8 b0 = *(const LAS bf16x8*)(VtT + (16 * n0 + fr) * 72 + 32 * ks + 8 * fq);
                    const bf16x8 b1 = *(const LAS bf16x8*)(VtT + (16 * (n0 + 1) + fr) * 72 + 32 * ks + 8 * fq);
                    o0 = __builtin_amdgcn_mfma_f32_16x16x32_bf16(av, b0, o0, 0, 0, 0);
                    o1 = __builtin_amdgcn_mfma_f32_16x16x32_bf16(av, b1, o1, 0, 0, 0);
                }
#pragma unroll
                for (int ks = 0; ks < 4; ++ks) {
                    const bf16x8 av = *(const LAS bf16x8*)(Qt + (16 * mt + fr) * 136 + 32 * ks + 8 * fq);
                    const bf16x8 b0 = *(const LAS bf16x8*)(SpT + (16 * n0 + fr) * 136 + 32 * ks + 8 * fq);
                    const bf16x8 b1 = *(const LAS bf16x8*)(SpT + (16 * (n0 + 1) + fr) * 136 + 32 * ks + 8 * fq);
                    o0 = __builtin_amdgcn_mfma_f32_16x16x32_bf16(av, b0, o0, 0, 0, 0);
                    o1 = __builtin_amdgcn_mfma_f32_16x16x32_bf16(av, b1, o1, 0, 0, 0);
                }
#pragma unroll
                for (int j = 0; j < 4; ++j) { const int t = 16 * mt + 4 * fq + j;
                    bf16_t* op = Op + (size_t)(r0 + t * rs) * D + 16 * n0 + fr;
                    op[0] = f2bf(o0[j]); op[16] = f2bf(o1[j]); }
            }
            {
                const f32x4 l4 = *(const LAS f32x4*)(el + 16 * wid + 4 * fq), lm4 = *(const LAS f32x4*)(elm + 16 * wid + 4 * fq);
#pragma unroll
                for (int n = 0; n < 4; ++n) { f32x4 d = (f32x4){0.f, 0.f, 0.f, 0.f};
#pragma unroll
                    for (int ks = 0; ks < 2; ++ks) {
                        const bf16x8 av = *(const LAS bf16x8*)(KtT + (16 * wid + fr) * 72 + 32 * ks + 8 * fq);
                        const bf16x8 bv = *(const LAS bf16x8*)(VtT + (16 * n + fr) * 72 + 32 * ks + 8 * fq);
                        d = __builtin_amdgcn_mfma_f32_16x16x32_bf16(av, bv, d, 0, 0, 0);
                    }
                    S[n] = l4 * S[n] + lm4 * d; }
            }
        }
        __syncthreads();
    }
}

__device__ __forceinline__ void phase_readout(KP a, int jm, int M, const int TID, const int BID, const int NBLK) {
    const int wid = TID >> 6, lane = TID & 63;
    bf16_t* Of = (bf16_t*)(a->ws + OFF_H);
    const bf16_t* Ob = (const bf16_t*)a->out;
    const bf16_t* P = (const bf16_t*)(a->ws + OFF_BIG);
    const float* gn = a->in[14] + jm * 128 + ((8 * lane) & 127);
    float gnv[8];
#pragma unroll
    for (int i = 0; i < 8; ++i) gnv[i] = gn[i];
    const int gw = BID * 8 + wid, NW = NBLK * 8;
    for (int row = gw; row < M; row += NW) {
        u32x4 fv[2], bv[2], gv[2];
#pragma unroll
        for (int hh = 0; hh < 2; ++hh) {
            fv[hh] = __builtin_nontemporal_load((const u32x4*)(Of + (size_t)row * D + 512 * hh + 8 * lane));
            bv[hh] = __builtin_nontemporal_load((const u32x4*)(Ob + (size_t)row * D + 512 * hh + 8 * lane));
            gv[hh] = __builtin_nontemporal_load((const u32x4*)(P + (size_t)row * NPROJ + 4096 + 512 * hh + 8 * lane)); }
#pragma unroll
        for (int hh = 0; hh < 2; ++hh) {
            const unsigned fw[4] = {fv[hh].x, fv[hh].y, fv[hh].z, fv[hh].w};
            const unsigned bw[4] = {bv[hh].x, bv[hh].y, bv[hh].z, bv[hh].w};
            const unsigned gw4[4] = {gv[hh].x, gv[hh].y, gv[hh].z, gv[hh].w};
            float o[8]; float ss = 0.f;
#pragma unroll
            for (int w = 0; w < 4; ++w) { o[2 * w] = bflo(fw[w]) + bflo(bw[w]); o[2 * w + 1] = bfhi(fw[w]) + bfhi(bw[w]); ss += o[2 * w] * o[2 * w] + o[2 * w + 1] * o[2 * w + 1]; }
            ss += __shfl_xor(ss, 1); ss += __shfl_xor(ss, 2); ss += __shfl_xor(ss, 4); ss += __shfl_xor(ss, 8);
            const float r = rsqrtf(ss * (1.f / 128.f) + EPS);
            u32x4 ov;
            ov.x = cvt_pk_bf16(o[0] * r * gnv[0] * bflo(gw4[0]), o[1] * r * gnv[1] * bfhi(gw4[0]));
            ov.y = cvt_pk_bf16(o[2] * r * gnv[2] * bflo(gw4[1]), o[3] * r * gnv[3] * bfhi(gw4[1]));
            ov.z = cvt_pk_bf16(o[4] * r * gnv[4] * bflo(gw4[2]), o[5] * r * gnv[5] * bfhi(gw4[2]));
            ov.w = cvt_pk_bf16(o[6] * r * gnv[6] * bflo(gw4[3]), o[7] * r * gnv[7] * bfhi(gw4[3]));
            *(u32x4*)(Of + (size_t)row * D + 512 * hh + 8 * lane) = ov;
        }
    }
}

template <class Epi>
__device__ __forceinline__ void run_gemm(LAS unsigned char* lds, const bf16_t* A, const bf16_t* Bt, int M, int N, int K, int lda, int ldb, int grpN, const Epi& E, const int TID, const int BID, const int NBLK, int splitk = 0) {
    pg8::Gemm g; g.A = A; g.Bt = Bt; g.M = M; g.N = N; g.K = K; g.lda = lda; g.ldb = ldb; g.grpN = grpN; g.splitk = splitk;
    pg8::StaticOrder S; S.init(M, N, NBLK, BID);
    if (splitk) { pg8::Unit u0; if (S.next(0, u0)) g.K = pg8::sk_len(u0.pn / grpN); }
    pg8::gemm_phase<Epi>(lds, g, S, E, TID);
}

__device__ __forceinline__ void run_phase(KP a, int ph, LAS unsigned char* lds, int parts = 7) {
    int TID = threadIdx.x, BID = blockIdx.x, NBLK = gridDim.x;
    asm volatile("" : "+v"(TID)); asm volatile("" : "+s"(BID)); asm volatile("" : "+s"(NBLK)); asm volatile("" : "+s"(lds));
    asm volatile("" : "+s"(a));
    unsigned char* ws = a->ws;
#ifndef SKIP_PRO
    if (ph == 0) { phase_prologue(a, lds, TID, BID, NBLK, parts); return; }
#endif
    const int q = ph - 1, L = q / 11, s = q % 11;
    const bf16_t* YF = (const bf16_t*)(ws + OFF_YFFN);
    const bf16_t* YM = (const bf16_t*)(ws + OFF_BIG);
    if (L == 4) { phase_ew(a, 3, 2, 0.5f, YF, -1, 0, false, MX, TID, BID, NBLK); return; }
    const bool last = (L == 3), hg = (L & 1);
    const int jm = L >> 1;
    const int Mmix = last ? MX : MT;
    int kind;
    if (s == 0 || s == 3 || s == 8) kind = 0;
    else if (s == 1 || s == 9) kind = 1;
    else if (s == 2 || s == 10 || s == 7) kind = 2;
    else if (s == 4) kind = 3;
    else if (s == 5) kind = hg ? 6 : 4;
    else kind = hg ? 7 : 5;
    if (kind == 0) {
#ifndef SKIP_EW
        if (s == 0) { if (L == 0) phase_ew(a, -1, 0, 0.f, YF, 0, 0, true, MT, TID, BID, NBLK); else phase_ew(a, L - 1, 2, 0.5f, YF, L, 0, false, MT, TID, BID, NBLK, (const bf16_t*)(ws + OFF_YP)); }
        else if (s == 3) phase_ew(a, L, 0, 0.5f, YF, L, 1, false, MT, TID, BID, NBLK, (const bf16_t*)(ws + OFF_YP));
        else phase_ew(a, L, 1, 1.0f, YM, L, 2, false, Mmix, TID, BID, NBLK);
#endif
    } else if (kind == 1) {
#ifndef SKIP_G1
        const int f = (s == 1) ? 0 : 1, M = (s == 1) ? MT : Mmix;
        pg8::EpiSwiglu E; E.O = (bf16_t*)(ws + OFF_BIG); E.ldc = DFF;
        run_gemm(lds, (const bf16_t*)(ws + OFF_H), (const bf16_t*)(ws + OFF_WIN + (size_t)(L * 2 + f) * SZ_WIN1), M, 2 * DFF, D, D, D, 0, E, TID, BID, NBLK);
#endif
    } else if (kind == 2) {
#ifndef SKIP_G2
        pg8::EpiBf16 E; E.act_lo_end = 0; E.act_hi_start = (1 << 30);
        const bf16_t* A2; const bf16_t* B2; int M2, K2; bf16_t* O2;
        if (s == 7) { O2 = (bf16_t*)(ws + OFF_BIG); A2 = (const bf16_t*)(ws + OFF_H); K2 = D; M2 = hg ? Mmix : MT;
            B2 = hg ? (const bf16_t*)(ws + OFF_WHOUT + (size_t)jm * SZ_SQ) : (const bf16_t*)(ws + OFF_WFO + (size_t)jm * SZ_SQ);
        } else { const int f = (s == 2) ? 0 : 1; M2 = (s == 2) ? MT : Mmix; O2 = (bf16_t*)(ws + OFF_YFFN); A2 = (const bf16_t*)(ws + OFF_BIG); K2 = DFF;
            B2 = (const bf16_t*)(ws + OFF_WOUT + (size_t)(L * 2 + f) * SZ_WOUT1); }
        const int npass = (s != 7 && M2 == MT) ? 2 : 1;
        for (int pass = 0; pass < npass; ++pass) {
            const bool sp = pass == 1;
            E.O = sp ? (bf16_t*)(ws + OFF_YP) : O2; E.ldc = sp ? 4096 : D;
            run_gemm(lds, sp ? A2 + (size_t)MX * DFF : A2, B2, sp ? MC : (npass == 2 ? MX : M2), sp ? 4096 : D, K2, K2, K2, sp ? 4 : 0, E, TID, BID, NBLK, sp ? 1 : 0);
        }
#endif
    } else if (kind == 3) {
#ifndef SKIP_G3
        pg8::EpiBf16 E; E.O = (bf16_t*)(ws + OFF_BIG); E.ldc = hg ? NPROJ : 2048; E.act_lo_end = hg ? 1024 : 0; E.act_hi_start = hg ? 4096 : (1 << 30);
        const bf16_t* B3 = hg ? (const bf16_t*)(ws + OFF_WHIN + (size_t)jm * SZ_WHIN1) : (const bf16_t*)(ws + OFF_WD1);
        run_gemm(lds, (const bf16_t*)(ws + OFF_H), B3, MT, hg ? NPROJ : 2048, hg ? D : 256, D, hg ? D : 256, hg ? 0 : 2, E, TID, BID, NBLK);
#endif
    } else if (kind == 4) {
#ifndef SKIP_T4
        token_stage_x<2>(lds, (const bf16_t*)(ws + OFF_BIG), (bf16_t*)(ws + OFF_Z2), (const bf16_t*)(ws + OFF_W2X), 0, TID, BID, NBLK);
        token_stage<256, 1>(lds, (const bf16_t*)(ws + OFF_BIG), (bf16_t*)(ws + OFF_H), (const bf16_t*)(ws + OFF_WC), 8, 2, TID, BID, NBLK);
#endif
    } else if (kind == 5) {
#ifndef SKIP_T5
        token_stage_x<1>(lds, (const bf16_t*)(ws + OFF_Z2), (bf16_t*)(ws + OFF_H), (const bf16_t*)(ws + OFF_W3X), 1, TID, BID, NBLK);
#endif
    } else if (kind == 6) {
#ifndef SKIP_SCAN
        phase_scan(a, lds, jm, TID, BID, NBLK);
#endif
    } else {
#ifndef SKIP_RO
        phase_readout(a, jm, Mmix, TID, BID, NBLK);
#endif
    }
}


#define XB_TMO      128
#define XB_XCNT(j)  (256  + 64 * (j))
#define XB_XSUB(j)  (1280 + 64 * (j))
#define XB_XGEN(j)  (2304 + 64 * (j))
#define XB_TOP      3328
#define XB_TOPGEN   3392
#define XCD_BAR_WORDS 3456
#define XB_SPIN_CAP (1u << 20)
__device__ __forceinline__ unsigned xb_ld(unsigned* p)              { return __hip_atomic_load(p, __ATOMIC_RELAXED, __HIP_MEMORY_SCOPE_AGENT); }
__device__ __forceinline__ unsigned xb_add(unsigned* p, unsigned v) { return __hip_atomic_fetch_add(p, v, __ATOMIC_RELAXED, __HIP_MEMORY_SCOPE_AGENT); }
__device__ __forceinline__ unsigned xb_xcc_id() { return (unsigned)__builtin_amdgcn_s_getreg((3 << 11) | 20) & 0xFu; }
#define XB_SPIN(cond, bar) do { unsigned _sp = 0; while (cond) { __builtin_amdgcn_s_sleep(1); \
    if ((++_sp & 255u) == 0u) { if (xb_ld(&(bar)[XB_TMO])) break; if (_sp > XB_SPIN_CAP) { atomicAdd(&(bar)[XB_TMO], 1u); break; } } } } while (0)
struct XcdBarrier { unsigned* bar; unsigned x; volatile LAS unsigned* st; };
__device__ __forceinline__ XcdBarrier xcd_barrier_post(unsigned* bar, volatile LAS unsigned* st) {
    XcdBarrier b; b.bar = bar; b.x = xb_xcc_id(); b.st = st;
    if (threadIdx.x == 0) (void)xb_add(&bar[XB_XCNT(b.x)], 1u);
    return b;
}
__device__ __forceinline__ void xcd_barrier_complete(unsigned* bar, unsigned x, unsigned& nloc, unsigned& nx) {
    const unsigned G = gridDim.x * gridDim.y * gridDim.z;
    unsigned sum, cnt, mine, sp = 0u;
    for (;;) {
        sum = 0u; cnt = 0u; mine = 0u;
#pragma unroll
        for (unsigned j = 0; j < 16; ++j) { const unsigned c = xb_ld(&bar[XB_XCNT(j)]); sum += c; cnt += (c > 0u) ? 1u : 0u; mine = (j == x) ? c : mine; }
        if (sum == G) break;
        __builtin_amdgcn_s_sleep(1);
        if ((++sp & 255u) == 0u) { if (xb_ld(&bar[XB_TMO])) break; if (sp > XB_SPIN_CAP) { atomicAdd(&bar[XB_TMO], 1u); break; } }
    }
    nloc = mine > 0u ? mine : 1u; nx = cnt > 0u ? cnt : 1u;
}
__device__ __forceinline__ void xcd_barrier(const XcdBarrier& b) {
    asm volatile("s_waitcnt vmcnt(0)" ::: "memory");
    __syncthreads();
    if (threadIdx.x == 0) {
        unsigned* bar = b.bar;
        __builtin_amdgcn_s_waitcnt(0);
        unsigned nloc = b.st[0], nx = b.st[1];
        if (nloc == 0u) { xcd_barrier_complete(bar, b.x, nloc, nx); b.st[0] = nloc; b.st[1] = nx; }
        const unsigned old = xb_add(&bar[XB_XSUB(b.x)], 1u);
        const unsigned gen = old / nloc;
        if (old + 1u == (gen + 1u) * nloc) {
            __builtin_amdgcn_fence(__ATOMIC_RELEASE, "agent");
            asm volatile("s_waitcnt vmcnt(0)" ::: "memory");
            const unsigned og = xb_add(&bar[XB_TOP], 1u);
            const unsigned tg = og / nx;
            if (og + 1u == (tg + 1u) * nx) xb_add(&bar[XB_TOPGEN], 1u);
            else XB_SPIN(xb_ld(&bar[XB_TOPGEN]) == tg, bar);
            __builtin_amdgcn_fence(__ATOMIC_ACQUIRE, "agent");
            xb_add(&bar[XB_XGEN(b.x)], 1u);
            asm volatile("s_waitcnt vmcnt(0)" ::: "memory");
        } else {
            XB_SPIN(xb_ld(&bar[XB_XGEN(b.x)]) == gen, bar);
            __builtin_amdgcn_fence(__ATOMIC_ACQUIRE, "agent");
            asm volatile("s_waitcnt vmcnt(0)" ::: "memory");
        }
    }
    __syncthreads();
}

extern "C" __global__ void __launch_bounds__(512, 2) fwd_megakernel(Args a) {
    extern __shared__ __attribute__((aligned(16))) unsigned char smem[];
    LAS unsigned char* lds = (LAS unsigned char*)smem;
    cg::grid_group grid = cg::this_grid();
    KP kp = (KP)__builtin_amdgcn_kernarg_segment_ptr();
    volatile LAS unsigned* xst = (volatile LAS unsigned*)(lds + 131072);
    if (threadIdx.x == 0) { xst[0] = 0u; xst[1] = 0u; }
    __syncthreads();
    XcdBarrier xb = xcd_barrier_post((unsigned*)(a.ws + OFF_BAR), xst);
#define GRID_SEAM(ph_) do { if ((ph_) == a.ph_lo) grid.sync(); else xcd_barrier(xb); } while (0)
    for (int ph = a.ph_lo; ph < a.ph_hi; ++ph) {
#ifdef REPEAT_MASK
        int reps = 1;
        { int q = ph - 1, L = q / 11, s = q % 11; bool hg = L & 1; int kind = -1;
          if (ph == 0) kind = 8; else if (L < 4) { if (s == 1 || s == 9) kind = 1; else if (s == 2 || s == 10 || s == 7) kind = 2; else if (s == 4) kind = 3; else if (s == 5) kind = hg ? 6 : 4; else if (s == 6) kind = hg ? 7 : 5; else kind = 0; }
          if (kind >= 0 && ((REPEAT_MASK >> kind) & 1)) reps = 2; }
        for (int r = 0; r < reps; ++r) { if (r) xcd_barrier(xb); run_phase(kp, ph, lds, (r && ph == 0) ? REPEAT_PARTS : 7); }
#else
        run_phase(kp, ph, lds);
#endif
        if (ph + 1 < a.ph_hi) GRID_SEAM(ph);
    }
}

extern "C" void kernel_launch(void* const* d_in, const int* in_sizes, int n_in, void* d_out, int out_size, void* d_ws, size_t ws_size, hipStream_t stream) {
    static int grid = 0;
    if (grid == 0) {
        if (n_in != 16 || ws_size < WS_END3) { fprintf(stderr, "kernel_launch: unexpected n_in %d / ws %zu (need %zu)\n", n_in, ws_size, (size_t)WS_END3); grid = -1; return; }
        int dev = 0, cus = 0, per_cu = 0;
        hipGetDevice(&dev);
        hipDeviceGetAttribute(&cus, hipDeviceAttributeMultiprocessorCount, dev);
        if (hipFuncSetAttribute((const void*)fwd_megakernel, hipFuncAttributeMaxDynamicSharedMemorySize, LDS_BYTES) != hipSuccess) { fprintf(stderr, "kernel_launch: hipFuncSetAttribute failed\n"); grid = -1; return; }
        hipOccupancyMaxActiveBlocksPerMultiprocessor(&per_cu, (const void*)fwd_megakernel, 512, LDS_BYTES);
        if (per_cu < 1) { fprintf(stderr, "kernel_launch: occupancy query says %d blocks per CU\n", per_cu); per_cu = 1; }
        (void)hipGetLastError();
        grid = cus * per_cu;
        if (grid > 256) grid = 256;
    }
    if (grid < 0) return;
    Args a{};
    for (int i = 0; i < 16; ++i) a.in[i] = (const float*)d_in[i];
    a.out = (float*)d_out; a.ws = (unsigned char*)d_ws;
#ifndef NPH_RUN
#define NPH_RUN NPH
#endif
#if MK_MULTI
    for (int ph = 0; ph < NPH_RUN; ++ph) { a.ph_lo = ph; a.ph_hi = ph + 1; hipLaunchKernelGGL(fwd_megakernel, dim3(grid), dim3(512), LDS_BYTES, stream, a); }
#else
    a.ph_lo = 0; a.ph_hi = NPH;
    if (hipMemsetAsync((char*)d_ws + OFF_BAR, 0, 16384, stream) != hipSuccess) { fprintf(stderr, "kernel_launch: memset of barrier words failed\n"); return; }
    void* args[] = {&a};
    hipError_t e = hipLaunchCooperativeKernel((const void*)fwd_megakernel, dim3(grid), dim3(512), args, LDS_BYTES, stream);
    if (e != hipSuccess) fprintf(stderr, "cooperative launch failed: %s (grid %d)\n", hipGetErrorString(e), grid);
#endif
}
```
